# Optimizing an MI355X kernel written in HIP

```python
import math
import jax, jax.numpy as jnp
from jax import lax
import numpy as np

D_MODEL = 2048
BATCH = 4
SEQ = 4096
DEPTH = 1

EPS = 1e-6
MLA_HEADS = 8
MLA_NOPE = 128
MLA_ROPE = 64
MLA_QK = MLA_NOPE + MLA_ROPE
MLA_V = 128
MLA_Q_RANK = 512
MLA_KV_RANK = 256
MLA_WIDTH = MLA_HEADS * MLA_V
ROPE_THETA = 10000.0
Q_BLOCK = 128
GLA_HEADS = 4
GLA_DK = 128
GLA_DV = 256
GLA_WIDTH = GLA_HEADS * GLA_DV
GLA_GATE_RANK = 16
GLA_TAU = 16.0
GLA_CHUNK = 64
PEER_HEADS = 8
PEER_NKEYS = 128
PEER_EXPERTS = PEER_NKEYS * PEER_NKEYS
PEER_QDIM = 256
PEER_HALF = PEER_QDIM // 2
PEER_TOPK = 16
PEER_TOKEN_BLOCK = 128
IN_SPLITS = (MLA_Q_RANK, MLA_KV_RANK, MLA_ROPE, GLA_HEADS * GLA_DK, GLA_HEADS * GLA_DK,
             GLA_WIDTH, GLA_GATE_RANK, GLA_WIDTH)
IN_WIDTH = MLA_Q_RANK + MLA_KV_RANK + MLA_ROPE + 2 * GLA_HEADS * GLA_DK + 2 * GLA_WIDTH + GLA_GATE_RANK
MIX_WIDTH = MLA_WIDTH + GLA_WIDTH

kernel_name = "hybrid_mla_gla_peer_adaln"


def rmsnorm(x, g):
    xf = x.astype(jnp.float32)
    y = xf * lax.rsqrt(jnp.mean(xf * xf, axis=-1, keepdims=True) + EPS)
    return (y * g.astype(jnp.float32)).astype(x.dtype)


def apply_rope(x, cos, sin):
    half = x.shape[-1] // 2
    x1, x2 = x[..., :half], x[..., half:]
    return jnp.concatenate([x1 * cos - x2 * sin, x2 * cos + x1 * sin], axis=-1)


def causal_block_attention(q, k, v):
    B, S, H, Dq = q.shape
    Dv = v.shape[-1]
    nb = S // Q_BLOCK
    qb = q.reshape(B, nb, Q_BLOCK, H, Dq).transpose(1, 0, 2, 3, 4)
    kpos = jnp.arange(S)
    scale = Dq ** -0.5

    def one_block(args):
        qi, bi = args
        s = jnp.einsum('bqhd,bkhd->bhqk', qi, k).astype(jnp.float32) * scale
        qpos = bi * Q_BLOCK + jnp.arange(Q_BLOCK)
        s = jnp.where(kpos[None, :] <= qpos[:, None], s, -jnp.inf)
        p = jax.nn.softmax(s, axis=-1).astype(v.dtype)
        return jnp.einsum('bhqk,bkhv->bqhv', p, v)

    out = lax.map(one_block, (qb, jnp.arange(nb)))
    return out.transpose(1, 0, 2, 3, 4).reshape(B, S, H, Dv)


def gla_chunked(q, k, v, log_a):
    B, S, H, dk = q.shape
    dv = v.shape[-1]
    C = GLA_CHUNK
    n = S // C

    def to_chunks(t):
        return t.reshape(B, n, C, H, t.shape[-1]).transpose(0, 3, 1, 2, 4)

    q, k, v, la = to_chunks(q), to_chunks(k), to_chunks(v), to_chunks(log_a)
    bcum = lax.cumsum(la, axis=3)
    b_last = bcum[:, :, :, -1:, :]
    b_mid = bcum[:, :, :, C // 2 - 1:C // 2, :]
    qe = q * jnp.exp(bcum - b_mid)
    ke = k * jnp.exp(b_mid - bcum)
    A = jnp.einsum('bhnid,bhnjd->bhnij', qe, ke)
    causal = jnp.tril(jnp.ones((C, C), dtype=bool))
    A = jnp.where(causal, A, 0.0)
    o_intra = jnp.einsum('bhnij,bhnjv->bhniv', A, v)
    U = jnp.einsum('bhnjd,bhnjv->bhndv', k * jnp.exp(b_last - bcum), v)
    decay = jnp.exp(b_last[:, :, :, 0, :])

    def step(state, inp):
        dec, u = inp
        return dec[..., None] * state + u, state

    S0 = jnp.zeros((B, H, dk, dv), q.dtype)
    _, S_before = lax.scan(step, S0, (decay.transpose(2, 0, 1, 3), U.transpose(2, 0, 1, 3, 4)))
    S_before = S_before.transpose(1, 2, 0, 3, 4)
    o_inter = jnp.einsum('bhnid,bhndv->bhniv', q * jnp.exp(bcum), S_before)
    o = o_intra + o_inter
    return o.transpose(0, 2, 3, 1, 4).reshape(B, S, H, dv)


def hybrid_mixer(h, cos, sin, w_in, q_norm_g, w_uq, kv_norm_g, w_ukv, mla_out_g,
                 gla_w_gate2, gla_b_gate, gla_out_g, w_out):
    B, S, _ = h.shape
    proj = h @ w_in
    offsets = [int(o) for o in np.cumsum(IN_SPLITS)[:-1]]
    cq, ckv, k_pe, gq, gk, gv, glr, gr = jnp.split(proj, offsets, axis=-1)

    q = (rmsnorm(cq, q_norm_g) @ w_uq).reshape(B, S, MLA_HEADS, MLA_QK)
    q_pe = apply_rope(q[..., MLA_NOPE:], cos[:, :, None, :], sin[:, :, None, :])
    q = jnp.concatenate([q[..., :MLA_NOPE], q_pe], axis=-1)
    kv = (rmsnorm(ckv, kv_norm_g) @ w_ukv).reshape(B, S, MLA_HEADS, MLA_NOPE + MLA_V)
    k_nope, v = kv[..., :MLA_NOPE], kv[..., MLA_NOPE:]
    k_pe = apply_rope(k_pe, cos, sin)
    k = jnp.concatenate([k_nope, jnp.broadcast_to(k_pe[:, :, None, :], (B, S, MLA_HEADS, MLA_ROPE))], axis=-1)
    o_mla = causal_block_attention(q, k, v)
    o_mla = rmsnorm(o_mla, mla_out_g.reshape(MLA_HEADS, MLA_V)).reshape(B, S, MLA_WIDTH)

    gq = gq.reshape(B, S, GLA_HEADS, GLA_DK).astype(jnp.float32) * (GLA_DK ** -0.5)
    gk = gk.reshape(B, S, GLA_HEADS, GLA_DK).astype(jnp.float32)
    gv = gv.reshape(B, S, GLA_HEADS, GLA_DV).astype(jnp.float32)
    log_a = jax.nn.log_sigmoid((glr @ gla_w_gate2 + gla_b_gate).astype(jnp.float32)) / GLA_TAU
    log_a = log_a.reshape(B, S, GLA_HEADS, GLA_DK)
    o_gla = gla_chunked(gq, gk, gv, log_a).astype(h.dtype)
    o_gla = rmsnorm(o_gla, gla_out_g.reshape(GLA_HEADS, GLA_DV)).reshape(B, S, GLA_WIDTH) * jax.nn.silu(gr)

    return jnp.concatenate([o_mla, o_gla], axis=-1) @ w_out


def peer_ffn(h, w_q, sub_keys, u_tab, v_tab):
    B, S, D = h.shape
    q = (h @ w_q).reshape(B, S, PEER_HEADS, 2, PEER_HALF)
    s = jnp.einsum('bshpd,hpkd->bshpk', q, sub_keys).astype(jnp.float32)
    top_s, top_i = lax.top_k(s, PEER_TOPK)
    cand = top_s[..., 0, :, None] + top_s[..., 1, None, :]
    cand = cand.reshape(B, S, PEER_HEADS, PEER_TOPK * PEER_TOPK)
    best_s, best_c = lax.top_k(cand, PEER_TOPK)
    i1 = jnp.take_along_axis(top_i[..., 0, :], best_c // PEER_TOPK, axis=-1)
    i2 = jnp.take_along_axis(top_i[..., 1, :], best_c % PEER_TOPK, axis=-1)
    expert = i1 * PEER_NKEYS + i2
    gate = jax.nn.softmax(best_s, axis=-1).astype(h.dtype)
    E = PEER_HEADS * PEER_TOPK
    nb = (B * S) // PEER_TOKEN_BLOCK
    xb = h.reshape(nb, PEER_TOKEN_BLOCK, D)
    eb = expert.reshape(nb, PEER_TOKEN_BLOCK, E)
    gb = gate.reshape(nb, PEER_TOKEN_BLOCK, E)

    def block(args):
        xt, et, gt = args
        u = jnp.take(u_tab, et, axis=0)
        act = jax.nn.gelu(jnp.einsum('td,ted->te', xt, u), approximate=False)
        return jnp.einsum('te,ted->td', gt * act, jnp.take(v_tab, et, axis=0))

    out = lax.map(block, (xb, eb, gb))
    return out.reshape(B, S, D)


def setup_inputs(seed: int = 0) -> dict:
    key = jax.random.key(seed)
    ks = jax.random.split(key, 24)
    L, D = DEPTH, D_MODEL
    f32 = jnp.float32

    def nrm(k, shape, scale):
        return jax.random.normal(k, shape, f32) * scale

    def gain(k, shape):
        return 1.0 + 0.02 * jax.random.normal(k, shape, f32)

    return {
        "x": nrm(ks[0], (BATCH, SEQ, D), 1.0),
        "c": nrm(ks[1], (BATCH, D), 1.0),
        "positions": jnp.broadcast_to(jnp.arange(SEQ, dtype=jnp.int32)[None, :], (BATCH, SEQ)),
        "ada_w": nrm(ks[2], (L, D, 6 * D), 0.5 * D ** -0.5),
        "ada_b": nrm(ks[3], (L, 6 * D), 0.02),
        "mix_norm_g": gain(ks[4], (L, D)),
        "w_in": nrm(ks[5], (L, D, IN_WIDTH), D ** -0.5),
        "mla_q_norm_g": gain(ks[6], (L, MLA_Q_RANK)),
        "mla_w_uq": nrm(ks[7], (L, MLA_Q_RANK, MLA_HEADS * MLA_QK), MLA_Q_RANK ** -0.5),
        "mla_kv_norm_g": gain(ks[8], (L, MLA_KV_RANK)),
        "mla_w_ukv": nrm(ks[9], (L, MLA_KV_RANK, MLA_HEADS * (MLA_NOPE + MLA_V)), MLA_KV_RANK ** -0.5),
        "mla_out_norm_g": gain(ks[10], (L, MLA_WIDTH)),
        "gla_w_gate2": nrm(ks[11], (L, GLA_GATE_RANK, GLA_HEADS * GLA_DK), GLA_GATE_RANK ** -0.5),
        "gla_b_gate": nrm(ks[12], (L, GLA_HEADS * GLA_DK), 0.1),
        "gla_out_norm_g": gain(ks[13], (L, GLA_WIDTH)),
        "w_out": nrm(ks[14], (L, MIX_WIDTH, D), MIX_WIDTH ** -0.5),
        "ffn_norm_g": gain(ks[15], (L, D)),
        "peer_w_q": nrm(ks[16], (L, D, PEER_HEADS * PEER_QDIM), D ** -0.5),
        "peer_sub_keys": nrm(ks[17], (L, PEER_HEADS, 2, PEER_NKEYS, PEER_HALF), PEER_HALF ** -0.5),
        "peer_u": nrm(ks[18], (L, PEER_EXPERTS, D), D ** -0.5),
        "peer_v": nrm(ks[19], (L, PEER_EXPERTS, D), 1.0),
        "final_norm_g": gain(ks[20], (D,)),
    }


def reference(x, c, positions, ada_w, ada_b, mix_norm_g, w_in, mla_q_norm_g, mla_w_uq,
              mla_kv_norm_g, mla_w_ukv, mla_out_norm_g, gla_w_gate2, gla_b_gate,
              gla_out_norm_g, w_out, ffn_norm_g, peer_w_q, peer_sub_keys, peer_u, peer_v,
              final_norm_g):
    inv_freq = ROPE_THETA ** (-jnp.arange(0, MLA_ROPE, 2, dtype=jnp.float32) / MLA_ROPE)
    ang = positions.astype(jnp.float32)[..., None] * inv_freq
    cos = jnp.cos(ang).astype(x.dtype)
    sin = jnp.sin(ang).astype(x.dtype)
    c_act = jax.nn.silu(c)
    for l in range(DEPTH):
        mod = (c_act @ ada_w[l] + ada_b[l])[:, None, :]
        sh1, sc1, g1, sh2, sc2, g2 = jnp.split(mod, 6, axis=-1)
        h = rmsnorm(x, mix_norm_g[l]) * (1.0 + sc1) + sh1
        x = x + g1 * hybrid_mixer(h, cos, sin, w_in[l], mla_q_norm_g[l], mla_w_uq[l],
                                  mla_kv_norm_g[l], mla_w_ukv[l], mla_out_norm_g[l],
                                  gla_w_gate2[l], gla_b_gate[l], gla_out_norm_g[l], w_out[l])
        h = rmsnorm(x, ffn_norm_g[l]) * (1.0 + sc2) + sh2
        x = x + g2 * peer_ffn(h, peer_w_q[l], peer_sub_keys[l], peer_u[l], peer_v[l])
    return rmsnorm(x, final_norm_g)
```

```cpp
#include <hip/hip_runtime.h>
#include <hip/hip_cooperative_groups.h>
#include <cstdio>
#include <cstdint>
namespace cg = cooperative_groups;

constexpr int NB = 4, SEQ = 4096, DM = 2048, NTOK = NB * SEQ;
constexpr float EPS = 1e-6f;
constexpr int NPROJ = 4096;
constexpr int PJ_CQ = 0, PJ_CKV = 512, PJ_GQ = 768, PJ_GK = 1280, PJ_GV = 1792, PJ_GR = 2816, PJ_KPE = 3840, PJ_GLR = 3904, PJ_END = 3920;
constexpr int MOD_SH1 = 0, MOD_SC1 = 2048, MOD_G1 = 4096, MOD_SH2 = 6144, MOD_SC2 = 8192, MOD_G2 = 10240, NMOD = 12288;
constexpr float QSCALE = 0.07216878364870322f * 1.4426950408889634f;
constexpr float GLA_QS = 0.08838834764831845f;

constexpr size_t MiB = 1u << 20;
constexpr size_t WS_CTL = 0, CTL_BYTES = 2 * MiB;
constexpr size_t CTL_BAR = 0, CTL_MODZI = 16384, CTL_SSQ = 409600, CTL_SSKV = 540672, CTL_SSX1 = 671744, CTL_MODZ = 802816, CTL_SSF = 1048576, CTL_QUEUE = 1048576 + 131072;
constexpr size_t WS_BTIN = 2 * MiB, WS_BTUQ = 18 * MiB, WS_BTUKV = 20 * MiB, WS_BTKEYS = 21 * MiB, WS_BTOUT = 22 * MiB, WS_BTQ = 30 * MiB;
constexpr size_t WS_CS = 38 * MiB, WS_KPE = 42 * MiB, WS_GATES = 44 * MiB, WS_EXPERTS = 52 * MiB, WS_DECAY = 60 * MiB;
constexpr size_t WS_UTAB = 64 * MiB, WS_VTAB = 96 * MiB, WS_USC = 61 * MiB, WS_VSC = 61 * MiB + 65536;
constexpr size_t WS_GLAU = 64 * MiB;
constexpr size_t WS_USH = 61 * MiB + 131072;
constexpr size_t WS_CSH = 61 * MiB + 524288;
constexpr size_t WS_Y = 128 * MiB;
constexpr size_t WS_EXP16 = 392 * MiB;
constexpr size_t WS_X1 = 432 * MiB;
constexpr size_t WS_HBUF = 192 * MiB;
constexpr size_t WS_PROJ = 256 * MiB;
constexpr size_t WS_BTK = 20 * MiB, WS_BTV = 20 * MiB + 524288;
constexpr size_t WS_K8 = 432 * MiB, WS_VT8 = 448 * MiB;
constexpr size_t WS_QMLA = 384 * MiB, WS_KV = 432 * MiB;
constexpr size_t WS_SCORES = 384 * MiB;
constexpr size_t WS_WTS = 384 * MiB;
constexpr size_t WS_PART = 256 * MiB;
constexpr size_t WS_NEED = 512 * MiB;

#define LAS __attribute__((address_space(3)))
typedef unsigned short bf16_t;
typedef short bf16x8 __attribute__((ext_vector_type(8)));
typedef int i32x4v __attribute__((ext_vector_type(4)));
typedef int i32x8v __attribute__((ext_vector_type(8)));
typedef short s16x4 __attribute__((ext_vector_type(4)));
typedef float f32x4 __attribute__((ext_vector_type(4)));
typedef float f32x2 __attribute__((ext_vector_type(2)));
typedef float f32x16 __attribute__((ext_vector_type(16)));
typedef unsigned u32x4 __attribute__((ext_vector_type(4)));
typedef unsigned u32x2 __attribute__((ext_vector_type(2)));
typedef __bf16 bf16x2_t __attribute__((ext_vector_type(2)));

__device__ __forceinline__ unsigned cvt_pk_bf16(float lo, float hi) { f32x2 v = {lo, hi}; bf16x2_t b = __builtin_convertvector(v, bf16x2_t); return __builtin_bit_cast(unsigned, b); }
__device__ __forceinline__ float bf_lo(unsigned w) { return __uint_as_float(w << 16); }
__device__ __forceinline__ float bf_hi(unsigned w) { return __uint_as_float(w & 0xffff0000u); }
__device__ __forceinline__ float bf2f(bf16_t h) { return __uint_as_float(((unsigned)h) << 16); }
__device__ __forceinline__ bf16_t f2bf(float f) { return (bf16_t)(cvt_pk_bf16(f, 0.f) & 0xffffu); }
__device__ __forceinline__ float dot2_bf16(unsigned a, unsigned b, float acc) { return __builtin_amdgcn_fdot2_f32_bf16(__builtin_bit_cast(bf16x2_t, a), __builtin_bit_cast(bf16x2_t, b), acc, false); }
template <int CTRL> __device__ __forceinline__ float dppf(float x) { return __builtin_bit_cast(float, __builtin_amdgcn_update_dpp(0, __builtin_bit_cast(int, x), CTRL, 0xF, 0xF, false)); }
__device__ __forceinline__ float lx1(float x) { return dppf<0xB1>(x); }
__device__ __forceinline__ float lx2(float x) { return dppf<0x4E>(x); }
__device__ __forceinline__ float lx7(float x) { return dppf<0x141>(x); }
__device__ __forceinline__ float lx8(float x) { return dppf<0x128>(x); }
__device__ __forceinline__ float lx16(float x, int lane) { auto r = __builtin_amdgcn_permlane16_swap(__float_as_uint(x), __float_as_uint(x), false, false); return __uint_as_float((lane & 16) ? r[0] : r[1]); }
__device__ __forceinline__ float lx32(float x, int lane) { auto r = __builtin_amdgcn_permlane32_swap(__float_as_uint(x), __float_as_uint(x), false, false); return __uint_as_float((lane & 32) ? r[0] : r[1]); }
__device__ __forceinline__ float wave_sum(float v) {
    v += lx1(v); v += lx2(v); v += lx7(v); v += lx8(v);
    { auto r = __builtin_amdgcn_permlane16_swap(__float_as_uint(v), __float_as_uint(v), false, false); v = __uint_as_float(r[0]) + __uint_as_float(r[1]); }
    { auto r = __builtin_amdgcn_permlane32_swap(__float_as_uint(v), __float_as_uint(v), false, false); v = __uint_as_float(r[0]) + __uint_as_float(r[1]); }
    return v;
}

typedef unsigned long long u64;
__device__ __forceinline__ void ss_add(u64* p, float v) { atomicAdd(p, (u64)((double)v * 4294967296.0)); }
__device__ __forceinline__ float ss_get(const u64* p) { return (float)((double)(*p) * (1.0 / 4294967296.0)); }
__device__ __forceinline__ void mz_add(u64* p, float v) { atomicAdd(p, (u64)(long long)((double)v * 1099511627776.0)); }
__device__ __forceinline__ float mz_get(const u64* p) { return (float)((double)(long long)(*p) * (1.0 / 1099511627776.0)); }

constexpr float FP8_SA = 32.f, FP8_SB = 2048.f;
__device__ __forceinline__ unsigned pk4_fp8(float a, float b, float c, float d, float S) {
    a = __builtin_amdgcn_fmed3f(a * S, -448.f, 448.f); b = __builtin_amdgcn_fmed3f(b * S, -448.f, 448.f); c = __builtin_amdgcn_fmed3f(c * S, -448.f, 448.f); d = __builtin_amdgcn_fmed3f(d * S, -448.f, 448.f);
    int p = __builtin_amdgcn_cvt_pk_fp8_f32(a, b, 0, false); p = __builtin_amdgcn_cvt_pk_fp8_f32(c, d, p, true); return (unsigned)p; }
constexpr float FP8_SQ = 256.f, FP8_SK = 32.f;
namespace pg8 {
constexpr int BM = 256, BK = 64, HALF = 128, HTB = HALF * BK * 2, STAGE_BYTES = 8 * HTB, NXCD = 8, WGM = 8;
__host__ __device__ __forceinline__ int lds_byte(int r, int c) { const int st = (r >> 4) * 2 + (c >> 5), rr = r & 15, cc = c & 31, ob = rr * 64 + cc * 2; return st * 1024 + (ob ^ (((ob >> 9) & 1) << 5)); }
__host__ __device__ __forceinline__ void stage_rc(int b, int& R, int& C) { const int st = b / 1024, sb = b % 1024, swz = sb ^ (((sb >> 9) & 1) << 5); R = (st >> 1) * 16 + swz / 64; C = (st & 1) * 32 + (swz % 64) / 2; }
__host__ __device__ __forceinline__ int perm32(int rho) { const int n = rho >> 4, i = rho & 15; return 8 * (i >> 2) + 4 * n + (i & 3); }

struct Unit { int pm, pn; };
struct Gemm { const bf16_t* A; const bf16_t* Bt; int M, N, K, lda, ldb, a_pn_stride; };

struct StaticOrder {
    int nM, nN, nwg, G, c;
    __host__ __device__ void init(int M, int N, int G_, int c_) { nM = M / BM; nN = N / BM; nwg = nM * nN; G = G_; c = c_; }
    __host__ __device__ bool next(int i, Unit& u) const {
        const long L = (long)i * G + c; if (L >= nwg) return false;
        int wgid = (int)L; { const int q = nwg / NXCD, r = nwg % NXCD, xcd = wgid % NXCD, off = wgid / NXCD; wgid = (xcd < r ? xcd * (q + 1) : r * (q + 1) + (xcd - r) * q) + off; }
        const int nig = WGM * nN, gid = wgid / nig, fm = gid * WGM, gsz = (nM - fm) < WGM ? (nM - fm) : WGM;
        u.pm = fm + ((wgid % nig) % gsz); u.pn = (wgid % nig) / gsz; return true;
    }
};

struct SingleUnit { Unit u0; __device__ __forceinline__ bool next(int i, Unit& u) const { if (i) return false; u = u0; return true; } };
template <bool FP8 = false, class Epi, class Sched>
__device__ __forceinline__ void gemm_phase(const int tid, LAS unsigned char* lds, const Gemm g, const Sched& S, const Epi& E) {
    const int wid = __builtin_amdgcn_readfirstlane(tid >> 6), lane = tid & 63, wr = wid >> 2, wc = wid & 3, fr = lane & 15, fq = lane >> 4;
    const int K = g.K, nt = K / BK;
    unsigned voffA[2], voffB[2];
#pragma unroll
    for (int i = 0; i < 2; ++i) { int R, C; stage_rc(tid * 16 + i * 8192, R, C); const int Rb = (R & ~31) + perm32(R & 31);
        voffA[i] = (unsigned)(R * g.lda + C) * 2u; voffB[i] = (unsigned)(Rb * g.ldb + C) * 2u; }
    const size_t kstep = (size_t)(BK * 2);
    const size_t hsA = (size_t)HALF * g.lda * 2, hsB = (size_t)HALF * g.ldb * 2;
    const size_t tsA = 2 * hsA, tsB = 2 * hsB;
    const unsigned ldsw = (unsigned)wid * 1024u;
    const int aoff = lds_byte(wr * 64 + fr, fq * 8), boff = lds_byte(wc * 32 + fr, fq * 8);
#define PG8_SA(b, h) (((b) * 2 + (h)) * HTB)
#define PG8_SB(b, h) ((4 + (b) * 2 + (h)) * HTB)
#define PG8_STAGE(bufoff, gbase, voff) do { _Pragma("unroll") for (int _i = 0; _i < 2; ++_i) \
        __builtin_amdgcn_global_load_lds((const unsigned*)((const char*)(gbase) + (voff)[_i]), (LAS unsigned*)(lds + (bufoff) + ldsw + _i * 8192), 16, 0, 0); } while (0)
#define PG8_LDA(dst, b, h) do { if constexpr (FP8) { _Pragma("unroll") for (int m = 0; m < 4; ++m) { const i32x4v lo_ = *(const LAS i32x4v*)(lds + PG8_SA(b, h) + aoff + m * 2048), hi_ = *(const LAS i32x4v*)(lds + PG8_SA(b, h) + aoff + m * 2048 + 1024); \
            dst##8[m] = __builtin_shufflevector(lo_, hi_, 0, 1, 2, 3, 4, 5, 6, 7); } }     \
        else { _Pragma("unroll") for (int m = 0; m < 4; ++m) _Pragma("unroll") for (int k = 0; k < 2; ++k) dst[m][k] = *(const LAS bf16x8*)(lds + PG8_SA(b, h) + aoff + m * 2048 + k * 1024); } } while (0)
#define PG8_LDB(dst, b, h) do { if constexpr (FP8) { _Pragma("unroll") for (int n = 0; n < 2; ++n) { const i32x4v lo_ = *(const LAS i32x4v*)(lds + PG8_SB(b, h) + boff + n * 2048), hi_ = *(const LAS i32x4v*)(lds + PG8_SB(b, h) + boff + n * 2048 + 1024); \
            dst##8[n] = __builtin_shufflevector(lo_, hi_, 0, 1, 2, 3, 4, 5, 6, 7); } } \
        else { _Pragma("unroll") for (int n = 0; n < 2; ++n) _Pragma("unroll") for (int k = 0; k < 2; ++k) dst[n][k] = *(const LAS bf16x8*)(lds + PG8_SB(b, h) + boff + n * 2048 + k * 1024); } } while (0)
#define PG8_MMA(ai, bj, At, Bt) do { __builtin_amdgcn_s_setprio(1); _Pragma("unroll") for (int m = 0; m < 4; ++m) _Pragma("unroll") for (int n = 0; n < 2; ++n) { \
        if constexpr (FP8) asm volatile("v_mfma_f32_16x16x128_f8f6f4 %0, %1, %2, %0" : "+v"(acc[ai][bj][m][n]) : "v"(Bt##8[n]), "v"(At##8[m]));     \
        else { _Pragma("unroll") for (int k = 0; k < 2; ++k) acc[ai][bj][m][n] = __builtin_amdgcn_mfma_f32_16x16x32_bf16(Bt[n][k], At[m][k], acc[ai][bj][m][n], 0, 0, 0); } } __builtin_amdgcn_s_setprio(0); } while (0)
#define PG8_WAIT_V(n) asm volatile("s_waitcnt vmcnt(" #n ")" ::: "memory")
#define PG8_WAIT_L(n) asm volatile("s_waitcnt lgkmcnt(" #n ")" ::: "memory")
#define PG8_BAR __builtin_amdgcn_s_barrier()
#define PG8_SCHED __builtin_amdgcn_sched_barrier(0)
    Unit cur, nxt; int ui = 0;
    if (!S.next(0, cur)) return;
    f32x4 acc[2][2][4][2];
#pragma unroll
    for (int a = 0; a < 2; ++a)
#pragma unroll
        for (int b = 0; b < 2; ++b)
#pragma unroll
            for (int m = 0; m < 4; ++m)
#pragma unroll
                for (int n = 0; n < 2; ++n) acc[a][b][m][n] = (f32x4){0.f, 0.f, 0.f, 0.f};
    bf16x8 At[4][2], B0[2][2], B1[2][2]; i32x8v At8[4], B08[2], B18[2];
    const char* cA = (const char*)g.A + (size_t)cur.pm * tsA + (size_t)cur.pn * g.a_pn_stride * 2; const char* cB = (const char*)g.Bt + (size_t)cur.pn * tsB;
    PG8_STAGE(PG8_SB(0, 0), cB, voffB); PG8_STAGE(PG8_SB(0, 1), cB + hsB, voffB); PG8_STAGE(PG8_SA(0, 0), cA, voffA); PG8_STAGE(PG8_SA(0, 1), cA + hsA, voffA);
    if (wr == 1) PG8_BAR;
    PG8_WAIT_V(2); PG8_BAR;
    PG8_STAGE(PG8_SB(1, 0), cB + kstep, voffB); PG8_STAGE(PG8_SA(1, 0), cA + kstep, voffA); PG8_STAGE(PG8_SB(1, 1), cB + hsB + kstep, voffB);
    PG8_WAIT_V(6); PG8_BAR;
    for (;;) {
        const bool has_next = S.next(ui + 1, nxt);
        const char* nA = has_next ? (const char*)g.A + (size_t)nxt.pm * tsA + (size_t)nxt.pn * g.a_pn_stride * 2 : cA; const char* nB = has_next ? (const char*)g.Bt + (size_t)nxt.pn * tsB : cB;
        for (int t = 0; t < nt; t += 2) {
            const bool last = (t == nt - 2);
            const char* a1 = cA + (size_t)(t + 1) * kstep;
            const char* a2 = last ? nA : cA + (size_t)(t + 2) * kstep; const char* b2 = last ? nB : cB + (size_t)(t + 2) * kstep;
            const char* a3 = a2 + kstep; const char* b3 = b2 + kstep;
            PG8_LDB(B0, 0, 0); PG8_LDB(B1, 0, 1); PG8_SCHED; PG8_LDA(At, 0, 0); PG8_STAGE(PG8_SA(1, 1), a1 + hsA, voffA);
            PG8_WAIT_V(8); PG8_WAIT_L(0); PG8_BAR; PG8_MMA(0, 0, At, B0); PG8_MMA(0, 1, At, B1); PG8_BAR; PG8_SCHED;
            PG8_LDA(At, 0, 1); PG8_STAGE(PG8_SB(0, 0), b2, voffB); PG8_STAGE(PG8_SB(0, 1), b2 + hsB, voffB); PG8_STAGE(PG8_SA(0, 0), a2, voffA);
            PG8_WAIT_V(8); PG8_WAIT_L(0); PG8_BAR; PG8_MMA(1, 0, At, B0); PG8_MMA(1, 1, At, B1); PG8_BAR; PG8_SCHED;
            PG8_LDB(B0, 1, 0); PG8_LDB(B1, 1, 1); PG8_SCHED; PG8_LDA(At, 1, 0); PG8_STAGE(PG8_SA(0, 1), a2 + hsA, voffA);
            PG8_WAIT_V(8); PG8_WAIT_L(0); PG8_BAR; PG8_MMA(0, 0, At, B0); PG8_MMA(0, 1, At, B1); PG8_BAR; PG8_SCHED;
            PG8_LDA(At, 1, 1); PG8_STAGE(PG8_SB(1, 0), b3, voffB); PG8_STAGE(PG8_SB(1, 1), b3 + hsB, voffB); PG8_STAGE(PG8_SA(1, 0), a3, voffA);
            PG8_WAIT_V(8); PG8_WAIT_L(0); PG8_BAR; PG8_MMA(1, 0, At, B0); PG8_MMA(1, 1, At, B1); PG8_BAR; PG8_SCHED;
        }
        if constexpr (FP8) asm volatile("s_nop 15\n\ts_nop 15" ::: "memory");
        if (wr == 0) PG8_BAR;
        if constexpr (!Epi::AFTER_DRAIN) E(acc, cur, wr, wc, fr, fq);
        if (!has_next) break;
#pragma unroll
        for (int a = 0; a < 2; ++a)
#pragma unroll
            for (int b = 0; b < 2; ++b)
#pragma unroll
                for (int m = 0; m < 4; ++m)
#pragma unroll
                    for (int n = 0; n < 2; ++n) acc[a][b][m][n] = (f32x4){0.f, 0.f, 0.f, 0.f};
        cur = nxt; cA = nA; cB = nB; ++ui;
        if (wr == 1) PG8_BAR;
    }
    PG8_WAIT_V(0);
    PG8_BAR;
    if constexpr (Epi::AFTER_DRAIN) E.fused(acc, cur, wr, wc, fr, fq, lds, tid);
#undef PG8_SA
#undef PG8_SB
#undef PG8_STAGE
#undef PG8_LDA
#undef PG8_LDB
#undef PG8_MMA
#undef PG8_WAIT_V
#undef PG8_WAIT_L
#undef PG8_BAR
#undef PG8_SCHED
}

#define EPI_LOOP_HEAD const int row0 = u.pm * BM + wr * 64 + fr; const int col0 = u.pn * BM + wc * 32 + 8 * fq;

struct EpiProj {
    static constexpr bool AFTER_DRAIN = false;
    bf16_t* O; int ldc; u64* ssq; u64* sskv; bool do_ss; float osc;
    __device__ __forceinline__ void operator()(const f32x4 (&acc)[2][2][4][2], const Unit& u, int wr, int wc, int fr, int fq) const {
        EPI_LOOP_HEAD
        u64* ssp = !do_ss ? nullptr : ((u.pn < 2) ? ssq : ((u.pn == 2) ? sskv : nullptr));
#pragma unroll
        for (int ai = 0; ai < 2; ++ai)
#pragma unroll
            for (int m = 0; m < 4; ++m) { const int row = row0 + ai * HALF + m * 16; bf16_t* rowp = O + (size_t)row * ldc + col0; float ss = 0.f;
#pragma unroll
                for (int bj = 0; bj < 2; ++bj) { const f32x4 v0 = acc[ai][bj][m][0] * osc, v1 = acc[ai][bj][m][1] * osc;
                    u32x4 w; w.x = cvt_pk_bf16(v0[0], v0[1]); w.y = cvt_pk_bf16(v0[2], v0[3]); w.z = cvt_pk_bf16(v1[0], v1[1]); w.w = cvt_pk_bf16(v1[2], v1[3]);
                    *(u32x4*)(rowp + bj * HALF) = w;
                    ss += bf_lo(w.x) * bf_lo(w.x) + bf_hi(w.x) * bf_hi(w.x) + bf_lo(w.y) * bf_lo(w.y) + bf_hi(w.y) * bf_hi(w.y)
                        + bf_lo(w.z) * bf_lo(w.z) + bf_hi(w.z) * bf_hi(w.z) + bf_lo(w.w) * bf_lo(w.w) + bf_hi(w.w) * bf_hi(w.w); }
                if (ssp) { ss += __shfl_xor(ss, 16); ss += __shfl_xor(ss, 32); if (fq == 0) ss_add(ssp + row, ss); } }
    }
};
struct EpiQ {
    static constexpr bool AFTER_DRAIN = false;
    unsigned char* O; const u64* ssq; const f32x2* cs;
    __device__ __forceinline__ void operator()(const f32x4 (&acc)[2][2][4][2], const Unit& u, int wr, int wc, int fr, int fq) const {
        EPI_LOOP_HEAD
#pragma unroll
        for (int ai = 0; ai < 2; ++ai)
#pragma unroll
            for (int m = 0; m < 4; ++m) { const int row = row0 + ai * HALF + m * 16; const float rs = rsqrtf(ss_get(ssq + row) * (1.f / 512.f) + EPS) * QSCALE;
#pragma unroll
                for (int bj = 0; bj < 2; ++bj) { const int col = col0 + bj * HALF; const int hd = col / 192, j = col - hd * 192;
                    f32x4 v0 = acc[ai][bj][m][0] * rs, v1 = acc[ai][bj][m][1] * rs;
                    if (j >= 128) { const int i0 = (j - 128) >> 1; const f32x4 c01 = *(const f32x4*)(cs + (size_t)row * 32 + i0), c23 = *(const f32x4*)(cs + (size_t)row * 32 + i0 + 2);
                        f32x4 r0, r1;
                        r0[0] = v0[0] * c01[0] - v0[1] * c01[1]; r0[1] = v0[1] * c01[0] + v0[0] * c01[1];
                        r0[2] = v0[2] * c01[2] - v0[3] * c01[3]; r0[3] = v0[3] * c01[2] + v0[2] * c01[3];
                        r1[0] = v1[0] * c23[0] - v1[1] * c23[1]; r1[1] = v1[1] * c23[0] + v1[0] * c23[1];
                        r1[2] = v1[2] * c23[2] - v1[3] * c23[3]; r1[3] = v1[3] * c23[2] + v1[2] * c23[3];
                        v0 = r0; v1 = r1; }
                    *(u32x2*)(O + (size_t)row * 1536 + col) = (u32x2){pk4_fp8(v0[0], v0[1], v0[2], v0[3], FP8_SQ), pk4_fp8(v1[0], v1[1], v1[2], v1[3], FP8_SQ)}; } }
    }
};
struct EpiK8 {
    static constexpr bool AFTER_DRAIN = false;
    unsigned char* O; const u64* sskv;
    __device__ __forceinline__ void operator()(const f32x4 (&acc)[2][2][4][2], const Unit& u, int wr, int wc, int fr, int fq) const {
        EPI_LOOP_HEAD
#pragma unroll
        for (int ai = 0; ai < 2; ++ai)
#pragma unroll
            for (int m = 0; m < 4; ++m) { const int row = row0 + ai * HALF + m * 16; const float rs = rsqrtf(ss_get(sskv + row) * (1.f / 256.f) + EPS);
#pragma unroll
                for (int bj = 0; bj < 2; ++bj) { const f32x4 v0 = acc[ai][bj][m][0] * rs, v1 = acc[ai][bj][m][1] * rs;
                    *(u32x2*)(O + (size_t)row * 1024 + col0 + bj * HALF) = (u32x2){pk4_fp8(v0[0], v0[1], v0[2], v0[3], FP8_SK), pk4_fp8(v1[0], v1[1], v1[2], v1[3], FP8_SK)}; } }
    }
};
struct EpiVT {
    static constexpr bool AFTER_DRAIN = false;
    unsigned char* O; const u64* sskv;
    __device__ __forceinline__ void operator()(const f32x4 (&acc)[2][2][4][2], const Unit& u, int wr, int wc, int fr, int fq) const {
        EPI_LOOP_HEAD
        f32x4 rs[2][2];
#pragma unroll
        for (int bj = 0; bj < 2; ++bj)
#pragma unroll
            for (int n = 0; n < 2; ++n)
#pragma unroll
                for (int q = 0; q < 4; ++q) rs[bj][n][q] = rsqrtf(ss_get(sskv + col0 + bj * HALF + 4 * n + q) * (1.f / 256.f) + EPS);
#pragma unroll
        for (int ai = 0; ai < 2; ++ai)
#pragma unroll
            for (int m = 0; m < 4; ++m) { const int row = row0 + ai * HALF + m * 16;
#pragma unroll
                for (int bj = 0; bj < 2; ++bj) { const f32x4 v0 = acc[ai][bj][m][0] * rs[bj][0], v1 = acc[ai][bj][m][1] * rs[bj][1];
                    *(u32x2*)(O + (size_t)row * NTOK + col0 + bj * HALF) = (u32x2){pk4_fp8(v0[0], v0[1], v0[2], v0[3], FP8_SK), pk4_fp8(v1[0], v1[1], v1[2], v1[3], FP8_SK)}; } }
    }
};
struct EpiOut {
    static constexpr bool AFTER_DRAIN = false;
    const float* x; bf16_t* x1b; bf16_t* yb; const float* modz; const float* ada_b; const float* ffn_g; u64* ssx1; bool do_ss; float osc;
    __device__ __forceinline__ void operator()(const f32x4 (&acc)[2][2][4][2], const Unit& u, int wr, int wc, int fr, int fq) const {
        EPI_LOOP_HEAD
        const int b = u.pm >> 4;
        f32x4 g[2][2], gm[2][2];
#pragma unroll
        for (int bj = 0; bj < 2; ++bj)
#pragma unroll
            for (int n = 0; n < 2; ++n) { const int col = col0 + bj * HALF + 4 * n;
                g[bj][n] = (*(const f32x4*)(modz + (size_t)b * NMOD + MOD_G1 + col) + *(const f32x4*)(ada_b + MOD_G1 + col)) * osc;
                gm[bj][n] = *(const f32x4*)(ffn_g + col) * (*(const f32x4*)(modz + (size_t)b * NMOD + MOD_SC2 + col) + *(const f32x4*)(ada_b + MOD_SC2 + col) + 1.f); }
#pragma unroll
        for (int ai = 0; ai < 2; ++ai)
#pragma unroll
            for (int m = 0; m < 4; ++m) { const int row = row0 + ai * HALF + m * 16; const size_t off = (size_t)row * DM + col0; float ss = 0.f;
#pragma unroll
                for (int bj = 0; bj < 2; ++bj) { f32x4 o[2];
#pragma unroll
                    for (int n = 0; n < 2; ++n) { const f32x4 xv = *(const f32x4*)(x + off + bj * HALF + 4 * n); o[n] = xv + g[bj][n] * acc[ai][bj][m][n];
                        ss += o[n][0] * o[n][0] + o[n][1] * o[n][1] + o[n][2] * o[n][2] + o[n][3] * o[n][3]; }
                    *(u32x4*)(x1b + off + bj * HALF) = (u32x4){cvt_pk_bf16(o[0][0], o[0][1]), cvt_pk_bf16(o[0][2], o[0][3]), cvt_pk_bf16(o[1][0], o[1][1]), cvt_pk_bf16(o[1][2], o[1][3])};
                    const f32x4 y0 = o[0] * gm[bj][0], y1 = o[1] * gm[bj][1];
                    *(u32x4*)(yb + off + bj * HALF) = (u32x4){cvt_pk_bf16(y0[0], y0[1]), cvt_pk_bf16(y0[2], y0[3]), cvt_pk_bf16(y1[0], y1[1]), cvt_pk_bf16(y1[2], y1[3])}; }
                ss += __shfl_xor(ss, 16); ss += __shfl_xor(ss, 32); if (fq == 0 && do_ss) ss_add(ssx1 + row, ss); }
    }
};
struct EpiBf16 {
    static constexpr bool AFTER_DRAIN = false;
    bf16_t* O; int ldc;
    __device__ __forceinline__ void operator()(const f32x4 (&acc)[2][2][4][2], const Unit& u, int wr, int wc, int fr, int fq) const {
        EPI_LOOP_HEAD
#pragma unroll
        for (int ai = 0; ai < 2; ++ai)
#pragma unroll
            for (int m = 0; m < 4; ++m) { const int row = row0 + ai * HALF + m * 16; bf16_t* rowp = O + (size_t)row * ldc + col0;
#pragma unroll
                for (int bj = 0; bj < 2; ++bj) { const f32x4 v0 = acc[ai][bj][m][0], v1 = acc[ai][bj][m][1];
                    u32x4 w; w.x = cvt_pk_bf16(v0[0], v0[1]); w.y = cvt_pk_bf16(v0[2], v0[3]); w.z = cvt_pk_bf16(v1[0], v1[1]); w.w = cvt_pk_bf16(v1[2], v1[3]);
                    *(u32x4*)(rowp + bj * HALF) = w; } }
    }
};
__device__ __forceinline__ unsigned skey_(float f) { const unsigned u = __float_as_uint(f); return (u & 0x80000000u) ? ~u : (u | 0x80000000u); }
__device__ __forceinline__ unsigned umin_(unsigned a, unsigned b) { return a < b ? a : b; }
__device__ __forceinline__ unsigned umax_(unsigned a, unsigned b) { return a > b ? a : b; }
__device__ __forceinline__ void ins16(unsigned (&L)[16], unsigned x) {
#pragma unroll
    for (int k = 15; k >= 1; --k) { unsigned r; asm("v_med3_u32 %0, %1, %2, %3" : "=v"(r) : "v"(L[k]), "v"(L[k - 1]), "v"(x)); L[k] = r; }
    L[0] = umax_(L[0], x);
}
struct EpiTopK {
    static constexpr bool AFTER_DRAIN = true;
    int* experts; float* gates; const u64* ssx1; const float* csh; unsigned short* exp16;
    __device__ __forceinline__ void fused(const f32x4 (&acc)[2][2][4][2], const Unit& u, int wr, int wc, int fr, int fq, LAS unsigned char* lds, int tid) const {
        constexpr int RS = 272;
        LAS float* S = (LAS float*)lds; LAS unsigned* SU = (LAS unsigned*)lds;
        int t2 = tid; asm volatile("" : "+v"(t2));
        const int r = t2 >> 2, p = (t2 >> 1) & 1, hf = t2 & 1;
        f32x4 cs4[2][2];
#pragma unroll
        for (int bj = 0; bj < 2; ++bj)
#pragma unroll
            for (int n = 0; n < 2; ++n) cs4[bj][n] = *(const f32x4*)(csh + (size_t)(u.pm >> 4) * DM + u.pn * BM + 128 * bj + 32 * wc + 8 * fq + 4 * n);
#pragma unroll
        for (int ai = 0; ai < 2; ++ai) {
#pragma unroll
            for (int m = 0; m < 4; ++m) { const float rstd = rsqrtf(ss_get(ssx1 + u.pm * BM + ai * HALF + 64 * wr + 16 * m + fr) * (1.f / DM) + EPS);
#pragma unroll
                for (int bj = 0; bj < 2; ++bj)
#pragma unroll
                    for (int n = 0; n < 2; ++n) { const int rr = 64 * wr + 16 * m + fr, c = 128 * bj + 32 * wc + 8 * fq + 4 * n; *(LAS f32x4*)(S + rr * RS + c + 4 * (c >> 6)) = acc[ai][bj][m][n] * rstd + cs4[bj][n]; } }
            asm volatile("s_waitcnt lgkmcnt(0)" ::: "memory"); __builtin_amdgcn_s_barrier(); asm volatile("" ::: "memory");
            unsigned L[16];
#pragma unroll
            for (int k = 0; k < 16; ++k) L[k] = 0u;
            { const LAS float* sp = S + r * RS + p * 128 + hf * 64 + 4 * (2 * p + hf);
#pragma unroll 4
              for (int i = 0; i < 16; ++i) { const f32x4 v = *(const LAS f32x4*)(sp + 4 * i);
#pragma unroll
                for (int e = 0; e < 4; ++e) ins16(L, (skey_(v[e]) & 0xFFFFFF80u) | (unsigned)(hf * 64 + 4 * i + e)); } }
            { unsigned P[16];
#pragma unroll
              for (int k = 0; k < 16; ++k) P[k] = __float_as_uint(lx1(__uint_as_float(L[k])));
#pragma unroll
              for (int k = 0; k < 16; ++k) ins16(L, P[k]); }
            float val[16];
#pragma unroll
            for (int k = 0; k < 16; ++k) { const int c = p * 128 + (int)(L[k] & 127u); val[k] = S[r * RS + c + 4 * (c >> 6)]; }
            asm volatile("s_waitcnt lgkmcnt(0)" ::: "memory"); __builtin_amdgcn_wave_barrier();
            if (hf == 0) {
#pragma unroll
                for (int k = 0; k < 16; ++k) { S[r * RS + p * 16 + k] = val[k]; SU[r * RS + 32 + p * 16 + k] = L[k] & 127u; } }
            asm volatile("s_waitcnt lgkmcnt(0)" ::: "memory"); __builtin_amdgcn_wave_barrier();
            if (p == 0 && hf == 0) {
                float s2[16];
#pragma unroll
                for (int k = 0; k < 16; ++k) s2[k] = S[r * RS + 16 + k];
                unsigned C[16];
#pragma unroll
                for (int k = 0; k < 16; ++k) C[k] = 0u;
#pragma unroll
                for (int a_ = 0; a_ < 16; ++a_)
#pragma unroll
                    for (int b_ = 0; b_ < 16; ++b_) if ((a_ + 1) * (b_ + 1) <= 16) ins16(C, (skey_(val[a_] + s2[b_]) & 0xFFFFFF00u) | (unsigned)(a_ * 16 + b_));
                float sv[16]; int ex[16]; float mx = -3.0e38f;
#pragma unroll
                for (int k = 0; k < 16; ++k) { const int a_ = (int)((C[k] >> 4) & 15u), b_ = (int)(C[k] & 15u);
                    sv[k] = S[r * RS + a_] + S[r * RS + 16 + b_]; ex[k] = (int)(SU[r * RS + 32 + a_] * 128u + SU[r * RS + 48 + b_]); mx = fmaxf(mx, sv[k]); }
                float sum = 0.f;
#pragma unroll
                for (int k = 0; k < 16; ++k) { sv[k] = __expf(sv[k] - mx); sum += sv[k]; }
                const float inv = 1.f / sum; const size_t o = (size_t)(u.pm * BM + ai * HALF + r) * 128 + u.pn * 16;
#pragma unroll
                for (int k = 0; k < 16; k += 4) { *(f32x4*)(gates + o + k) = (f32x4){sv[k] * inv, sv[k + 1] * inv, sv[k + 2] * inv, sv[k + 3] * inv};
                    *(u32x4*)(experts + o + k) = (u32x4){(unsigned)ex[k], (unsigned)ex[k + 1], (unsigned)ex[k + 2], (unsigned)ex[k + 3]};
                    *(u32x2*)(exp16 + o + k) = (u32x2){(unsigned)ex[k] | ((unsigned)ex[k + 1] << 16), (unsigned)ex[k + 2] | ((unsigned)ex[k + 3] << 16)}; } }
            asm volatile("s_waitcnt lgkmcnt(0)" ::: "memory"); __builtin_amdgcn_s_barrier(); asm volatile("" ::: "memory"); }
    }
};
#undef EPI_LOOP_HEAD
}

struct Args {
    const float* x; const float* c; const int* pos; const float* ada_w; const float* ada_b; const float* mix_g; const float* w_in; const float* qn_g; const float* w_uq;
    const float* kvn_g; const float* w_ukv; const float* mla_og; const float* w_gate2; const float* b_gate; const float* gla_og; const float* w_out; const float* ffn_g;
    const float* w_q; const float* sub_keys; const float* u_tab; const float* v_tab; const float* fin_g;
    float* out; unsigned char* ws; int ph_lo, ph_hi;
};

constexpr int NTHREADS = 512, NWAVES = 8;
constexpr int LDS_BYTES = 147456;
constexpr int MISC_OFF_PRE = LDS_BYTES - 64 + 16;

typedef const __attribute__((address_space(4))) Args* ArgsP;
__device__ __forceinline__ Args fresh_args() {
#if defined(__HIP_DEVICE_COMPILE__)
    ArgsP p = (ArgsP)__builtin_amdgcn_kernarg_segment_ptr(); asm volatile("" : "+s"(p)); return *p;
#else
    return Args{};
#endif
}

__device__ __forceinline__ int src_col_in(int n) {
    if (n < 768) return n;
    if (n < 1280) return 832 + (n - 768);
    if (n < 1792) return 1344 + (n - 1280);
    if (n < 2816) return 1856 + (n - 1792);
    if (n < 3840) return 2896 + (n - 2816);
    if (n < 3904) { const int j = n - 3840; return 768 + (j & 1) * 32 + (j >> 1); }
    if (n < 3920) return 2880 + (n - 3904);
    return -1;
}
__device__ __forceinline__ int src_col_kv(int n, int o) { return (n >> 7) * 256 + o + (n & 127); }
__device__ __forceinline__ int src_col_uq(int n) { const int hd = n / 192, j = n - hd * 192; if (j < 128) return n; const int jj = j - 128; return hd * 192 + 128 + (jj & 1) * 32 + (jj >> 1); }

template <int MAP>
__device__ __forceinline__ void transpose_item(const float* W, int K, int Nsrc, int Ndst, const float* kscale, bf16_t* Bt, float* scr, int item, int lane) {
    const int nblk = Ndst / 32, kb = item / nblk, nb = item % nblk, k0 = 64 * kb, n0 = 32 * nb;
    const int n = n0 + (lane & 31); const int sc = MAP == 1 ? src_col_in(n) : (MAP == 2 ? src_col_uq(n) : (MAP == 4 ? src_col_kv(n, 0) : (MAP == 5 ? src_col_kv(n, 128) : n)));
    const int sc0 = MAP == 1 ? src_col_in(n0) : (MAP == 2 ? src_col_uq(n0) : (MAP == 4 ? src_col_kv(n0, 0) : (MAP == 5 ? src_col_kv(n0, 128) : n0)));
    const int sc31 = MAP == 1 ? src_col_in(n0 + 31) : (MAP == 2 ? src_col_uq(n0 + 31) : (MAP == 4 ? src_col_kv(n0 + 31, 0) : (MAP == 5 ? src_col_kv(n0 + 31, 128) : n0 + 31)));
    if (sc0 >= 0 && sc31 - sc0 == 31 && ((sc0 | Nsrc) & 3) == 0) {
        const int kr = lane >> 3, nq = lane & 7; f32x4 v[8];
#pragma unroll
        for (int i = 0; i < 8; ++i) v[i] = *(const f32x4*)(W + (size_t)(k0 + 8 * i + kr) * Nsrc + sc0 + 4 * nq);
#pragma unroll
        for (int i = 0; i < 8; ++i) { const int kk = 8 * i + kr; const float ks = kscale ? kscale[k0 + kk] : 1.f;
            scr[kk * 33 + 4 * nq + 0] = v[i][0] * ks; scr[kk * 33 + 4 * nq + 1] = v[i][1] * ks; scr[kk * 33 + 4 * nq + 2] = v[i][2] * ks; scr[kk * 33 + 4 * nq + 3] = v[i][3] * ks; }
    } else {
#pragma unroll 16
    for (int i = 0; i < 32; ++i) { const int kk = 2 * i + (lane >> 5); float v = 0.f; if (sc >= 0) v = W[(size_t)(k0 + kk) * Nsrc + sc]; if (kscale) v *= kscale[k0 + kk]; scr[kk * 33 + (lane & 31)] = v; }
    }
    __builtin_amdgcn_wave_barrier(); asm volatile("s_waitcnt lgkmcnt(0)" ::: "memory");
    const int c = lane & 7;
#pragma unroll
    for (int j = 0; j < 4; ++j) { const int nn = (lane >> 3) + 8 * j; const float* s = scr + (8 * c) * 33 + nn;
        if (MAP == 1 || MAP == 3) { u32x2 o8; o8.x = pk4_fp8(s[0 * 33], s[1 * 33], s[2 * 33], s[3 * 33], FP8_SB); o8.y = pk4_fp8(s[4 * 33], s[5 * 33], s[6 * 33], s[7 * 33], FP8_SB);
            *(u32x2*)((unsigned char*)Bt + (size_t)(n0 + nn) * K + k0 + 8 * c) = o8; continue; }
        u32x4 o; o.x = cvt_pk_bf16(s[0 * 33], s[1 * 33]); o.y = cvt_pk_bf16(s[2 * 33], s[3 * 33]); o.z = cvt_pk_bf16(s[4 * 33], s[5 * 33]); o.w = cvt_pk_bf16(s[6 * 33], s[7 * 33]);
        *(u32x4*)(Bt + (size_t)(n0 + nn) * K + k0 + 8 * c) = o; }
    __builtin_amdgcn_wave_barrier(); asm volatile("s_waitcnt lgkmcnt(0)" ::: "memory");
}

__device__ __forceinline__ void phase_p0(const int tid, const Args& a, char* lds, const bool do_mod) {
    const int lane = tid & 63, wave = __builtin_amdgcn_readfirstlane(tid >> 6), bx = blockIdx.x, G = gridDim.x;
    unsigned char* ws = a.ws;
    { float* cact = (float*)lds;
      u64* modz = (u64*)(ws + WS_CTL + CTL_MODZI);
      for (int it = do_mod ? bx : 256; it < 256; it += G) { const int cgp = it & 7, kg = it >> 3;
        __syncthreads();
        if (tid < 256) { const int bt = tid >> 6, kk = tid & 63; const float cv = a.c[bt * DM + kg * 64 + kk]; cact[tid] = cv / (1.f + __expf(-cv)); }
        __syncthreads();
        if (tid < 384) { const int col = cgp * 1536 + 4 * tid; f32x4 ac[4] = {};
            const float* wp = a.ada_w + (size_t)(kg * 64) * NMOD + col;
#pragma unroll 16
            for (int kk = 0; kk < 64; ++kk) { const f32x4 w = *(const f32x4*)(wp + (size_t)kk * NMOD);
#pragma unroll
                for (int bt = 0; bt < 4; ++bt) ac[bt] += w * cact[bt * 64 + kk]; }
#pragma unroll
            for (int bt = 0; bt < 4; ++bt)
#pragma unroll
                for (int q = 0; q < 4; ++q) mz_add(modz + (size_t)bt * NMOD + col + q, ac[bt][q]); }
      }
      __syncthreads(); }
    { float* scr = (float*)(lds + wave * 8448);
      const int gw = bx * NWAVES + wave, NGW = G * NWAVES;
      constexpr int I_IN = 32 * 128, I_UQ = 8 * 48, I_UKV = 2 * 4 * 32, I_OUT = 32 * 64;
      for (int it = gw; it < I_IN + I_UQ + I_UKV + I_OUT; it += NGW) { int r = it;
        if (r < I_IN) { transpose_item<1>(a.w_in, 2048, 3920, 4096, nullptr, (bf16_t*)(ws + WS_BTIN), scr, r, lane); continue; } r -= I_IN;
        if (r < I_UQ) { transpose_item<2>(a.w_uq, 512, 1536, 1536, a.qn_g, (bf16_t*)(ws + WS_BTUQ), scr, r, lane); continue; } r -= I_UQ;
        if (r < I_UKV) { if (r < 128) transpose_item<4>(a.w_ukv, 256, 2048, 1024, a.kvn_g, (bf16_t*)(ws + WS_BTK), scr, r, lane); else transpose_item<5>(a.w_ukv, 256, 2048, 1024, a.kvn_g, (bf16_t*)(ws + WS_BTV), scr, r - 128, lane); continue; } r -= I_UKV;
        transpose_item<3>(a.w_out, 2048, 2048, 2048, nullptr, (bf16_t*)(ws + WS_BTOUT), scr, r, lane); } }
    __syncthreads();
    { const int gw = bx * NWAVES + wave, NGW = G * NWAVES, fr = lane & 15, fq = lane >> 4; bf16_t* bte = (bf16_t*)(ws + WS_BTQ);
#define SPLIT8(P_, HI_, LO_) do { const f32x4 x0_ = *(const f32x4*)(P_), x1_ = *(const f32x4*)((P_) + 4); const float xs_[8] = {x0_[0], x0_[1], x0_[2], x0_[3], x1_[0], x1_[1], x1_[2], x1_[3]}; u32x4 h_, l_; \
        _Pragma("unroll") for (int q_ = 0; q_ < 4; ++q_) { const unsigned hp_ = cvt_pk_bf16(xs_[2 * q_], xs_[2 * q_ + 1]); h_[q_] = hp_; \
            l_[q_] = cvt_pk_bf16(xs_[2 * q_] - __uint_as_float(hp_ << 16), xs_[2 * q_ + 1] - __uint_as_float(hp_ & 0xffff0000u)); } \
        HI_ = __builtin_bit_cast(bf16x8, h_); LO_ = __builtin_bit_cast(bf16x8, l_); } while (0)
      for (int it = gw; it < 64 * 32; it += NGW) { const int nb = it >> 5, kb = it & 31, n0 = nb * 32, k0 = kb * 64, hp = n0 >> 7;
        f32x4 acc[2][4];
#pragma unroll
        for (int na = 0; na < 2; ++na)
#pragma unroll
            for (int kt = 0; kt < 4; ++kt) acc[na][kt] = (f32x4){0.f, 0.f, 0.f, 0.f};
#pragma unroll
        for (int ks = 0; ks < 4; ++ks) { bf16x8 ah[2], al[2];
#pragma unroll
            for (int na = 0; na < 2; ++na) { const float* p = a.sub_keys + (size_t)(n0 + 16 * na + fr) * 128 + 32 * ks + 8 * fq; SPLIT8(p, ah[na], al[na]); }
#pragma unroll
            for (int kt = 0; kt < 4; ++kt) { const float* p = a.w_q + (size_t)(k0 + 16 * kt + fr) * 2048 + hp * 128 + 32 * ks + 8 * fq; bf16x8 bh, bl; SPLIT8(p, bh, bl);
#pragma unroll
                for (int na = 0; na < 2; ++na) { acc[na][kt] = __builtin_amdgcn_mfma_f32_16x16x32_bf16(ah[na], bh, acc[na][kt], 0, 0, 0);
                    acc[na][kt] = __builtin_amdgcn_mfma_f32_16x16x32_bf16(ah[na], bl, acc[na][kt], 0, 0, 0); acc[na][kt] = __builtin_amdgcn_mfma_f32_16x16x32_bf16(al[na], bh, acc[na][kt], 0, 0, 0); } } }
#pragma unroll
        for (int na = 0; na < 2; ++na)
#pragma unroll
            for (int kt = 0; kt < 4; ++kt)
#pragma unroll
                for (int r = 0; r < 4; ++r) { const float v = acc[na][kt][r], vn = lx1(v);
                    if ((fr & 1) == 0) *(unsigned*)(bte + (size_t)(n0 + 16 * na + 4 * fq + r) * 2048 + k0 + 16 * kt + fr) = cvt_pk_bf16(v, vn); } }
#undef SPLIT8
    }
    { const int gt = bx * NTHREADS + tid, NGT = G * NTHREADS;
      f32x2* cs = (f32x2*)(ws + WS_CS);
      for (int i = gt; i < NTOK * 32; i += NGT) { const int tok = i >> 5, fi = i & 31;
        const float inv_freq = powf(10000.f, -(float)(2 * fi) * (1.f / 64.f)); const float ang = (float)a.pos[tok] * inv_freq;
        const double rev = (double)ang * 0.15915494309189535; const float fr = (float)(rev - rint(rev));
        cs[i] = (f32x2){__builtin_amdgcn_cosf(fr), __builtin_amdgcn_sinf(fr)}; } }
}

template <bool SECOND>
__device__ __forceinline__ void phase_rows(const int tid, const Args& a) {
    const int lane = tid & 63, wave = __builtin_amdgcn_readfirstlane(tid >> 6), gw = blockIdx.x * NWAVES + wave, NGW = gridDim.x * NWAVES;
    const float* modz = (const float*)(a.ws + WS_CTL + CTL_MODZ); const u64* modzi = (const u64*)(a.ws + WS_CTL + CTL_MODZI); const u64* ssx1 = (const u64*)(a.ws + WS_CTL + CTL_SSX1);
    if (!SECOND) { float* mf = (float*)(a.ws + WS_CTL + CTL_MODZ);
        for (int i = blockIdx.x * NTHREADS + tid; i < 4 * NMOD; i += gridDim.x * NTHREADS) mf[i] = mz_get(modzi + i); }
    const float* xin = SECOND ? a.out : a.x; const float* gain = SECOND ? a.ffn_g : a.mix_g; bf16_t* hb = (bf16_t*)(a.ws + WS_HBUF);
    constexpr int OSH = SECOND ? MOD_SH2 : MOD_SH1, OSC = SECOND ? MOD_SC2 : MOD_SC1;
    for (int grp = gw; grp < NTOK / 8; grp += NGW) { const int row0 = grp * 8, b = row0 >> 12;
        f32x4 gm[8], sh[8];
#pragma unroll
        for (int j = 0; j < 8; ++j) { const int col = 256 * j + 4 * lane;
            f32x4 zc, zh;
            if (SECOND) { zc = *(const f32x4*)(modz + (size_t)b * NMOD + OSC + col); zh = *(const f32x4*)(modz + (size_t)b * NMOD + OSH + col); }
            else {
#pragma unroll
                for (int q = 0; q < 4; ++q) { zc[q] = mz_get(modzi + (size_t)b * NMOD + OSC + col + q); zh[q] = mz_get(modzi + (size_t)b * NMOD + OSH + col + q); } }
            const f32x4 g = *(const f32x4*)(gain + col), sc = zc + *(const f32x4*)(a.ada_b + OSC + col);
            gm[j] = g * (sc + 1.f); sh[j] = zh + *(const f32x4*)(a.ada_b + OSH + col); }
        f32x4 va[8], vb[8];
#pragma unroll
        for (int j = 0; j < 8; ++j) va[j] = __builtin_nontemporal_load((const f32x4*)(xin + (size_t)row0 * DM + 4 * lane + 256 * j));
#pragma unroll
        for (int j = 0; j < 8; ++j) vb[j] = __builtin_nontemporal_load((const f32x4*)(xin + (size_t)(row0 + 1) * DM + 4 * lane + 256 * j));
#define ROWSTEP(VB, r_) do { const int r = (r_), row = row0 + r; \
            f32x4 v[8]; float s = 0.f; \
            _Pragma("unroll") for (int j = 0; j < 8; ++j) { v[j] = VB[j]; s += v[j][0] * v[j][0] + v[j][1] * v[j][1] + v[j][2] * v[j][2] + v[j][3] * v[j][3]; } \
            { const int rn = r + 2 < 8 ? row + 2 : row;                                   \
              _Pragma("unroll") for (int j = 0; j < 8; ++j) VB[j] = __builtin_nontemporal_load((const f32x4*)(xin + (size_t)rn * DM + 4 * lane + 256 * j)); } \
            float tot; if (SECOND) tot = ss_get(ssx1 + row); else tot = wave_sum(s); \
            const float rstd = rsqrtf(tot * (1.f / DM) + EPS); \
            bf16_t* op = hb + (size_t)row * DM + 4 * lane; \
            _Pragma("unroll") for (int j = 0; j < 8; ++j) { const f32x4 o = v[j] * rstd * gm[j] + sh[j]; \
                if (!SECOND) *(unsigned*)((unsigned char*)hb + (size_t)row * DM + 4 * lane + 256 * j) = pk4_fp8(o[0], o[1], o[2], o[3], FP8_SA);     \
                else { u32x2 w; w.x = cvt_pk_bf16(o[0], o[1]); w.y = cvt_pk_bf16(o[2], o[3]); *(u32x2*)(op + 256 * j) = w; } } } while (0)
#pragma unroll 1
        for (int r2 = 0; r2 < 8; r2 += 2) { ROWSTEP(va, r2); ROWSTEP(vb, r2 + 1); }
#undef ROWSTEP
    }
}
__device__ __forceinline__ void phase_tables(const int tid, const Args& a, char* lds) {
    const int lane = tid & 63, gw = blockIdx.x * NWAVES + __builtin_amdgcn_readfirstlane(tid >> 6), NGW = gridDim.x * NWAVES;
    unsigned char* ub = a.ws + WS_UTAB; unsigned char* vb = a.ws + WS_VTAB; float* usc = (float*)(a.ws + WS_USC); float* vsc = (float*)(a.ws + WS_VSC); float* ush = (float*)(a.ws + WS_USH);
    float* sh2 = (float*)lds; const float* modz = (const float*)(a.ws + WS_CTL + CTL_MODZ);
    __syncthreads();
    for (int i = tid; i < 4 * DM / 4; i += NTHREADS) { const int b = i >> 9, c = 4 * (i & 511); *(f32x4*)(sh2 + b * DM + c) = *(const f32x4*)(modz + (size_t)b * NMOD + MOD_SH2 + c) + *(const f32x4*)(a.ada_b + MOD_SH2 + c); }
    __syncthreads();
    { const bf16_t* wt = (const bf16_t*)(a.ws + WS_BTQ); float* csh = (float*)(a.ws + WS_CSH);
      for (int n = gw; n < DM; n += NGW) { float d[4] = {0.f, 0.f, 0.f, 0.f};
#pragma unroll
        for (int j = 0; j < 4; ++j) { const int k = 512 * j + 8 * lane; const u32x4 w = *(const u32x4*)(wt + (size_t)n * DM + k);
            const float wf[8] = {bf_lo(w.x), bf_hi(w.x), bf_lo(w.y), bf_hi(w.y), bf_lo(w.z), bf_hi(w.z), bf_lo(w.w), bf_hi(w.w)};
#pragma unroll
            for (int b = 0; b < 4; ++b) { const f32x4 s0 = *(const f32x4*)(sh2 + b * DM + k), s1 = *(const f32x4*)(sh2 + b * DM + k + 4);
                d[b] += wf[0] * s0[0] + wf[1] * s0[1] + wf[2] * s0[2] + wf[3] * s0[3] + wf[4] * s1[0] + wf[5] * s1[1] + wf[6] * s1[2] + wf[7] * s1[3]; } }
#pragma unroll
        for (int b = 0; b < 4; ++b) { const float t = wave_sum(d[b]); if (lane == 0) csh[b * DM + n] = t; } } }
#define TB_LOAD(V, r_) do { const int rr_ = (r_) < 2 * 16384 ? (r_) : 2 * 16384 - 1; const float* src = (rr_ >= 16384 ? a.v_tab + (size_t)(rr_ - 16384) * DM : a.u_tab + (size_t)rr_ * DM) + 4 * lane; \
        _Pragma("unroll") for (int j = 0; j < 2; ++j) _Pragma("unroll") for (int q = 0; q < 4; ++q) V[j][q] = __builtin_nontemporal_load((const f32x4*)(src + 256 * (4 * j + q))); } while (0)
#define TB_STORE(V, r) do { const bool second = (r) >= 16384; const int row = second ? (r) - 16384 : (r); float mx = 0.f; \
        _Pragma("unroll") for (int j = 0; j < 2; ++j) _Pragma("unroll") for (int q = 0; q < 4; ++q) mx = fmaxf(mx, fmaxf(fmaxf(fabsf(V[j][q][0]), fabsf(V[j][q][1])), fmaxf(fabsf(V[j][q][2]), fabsf(V[j][q][3])))); \
        mx = fmaxf(mx, lx1(mx)); mx = fmaxf(mx, lx2(mx)); mx = fmaxf(mx, lx7(mx)); mx = fmaxf(mx, lx8(mx)); mx = fmaxf(mx, lx16(mx, lane)); mx = fmaxf(mx, lx32(mx, lane)); \
        int e = (int)((__float_as_uint(mx) >> 23) & 0xffu) - 127; if (mx == 0.f) e = 7; if (e < -100) e = -100; if (e > 100) e = 100; \
        const float sc = __uint_as_float((unsigned)(127 + 7 - e) << 23), inv = __uint_as_float((unsigned)(127 - 7 + e) << 23); \
        unsigned char* tb = (second ? vb : ub); \
        _Pragma("unroll") for (int j = 0; j < 2; ++j) \
            _Pragma("unroll") for (int q = 0; q < 4; ++q) { int p = __builtin_amdgcn_cvt_pk_fp8_f32(V[j][q][0] * sc, V[j][q][1] * sc, 0, false); p = __builtin_amdgcn_cvt_pk_fp8_f32(V[j][q][2] * sc, V[j][q][3] * sc, p, true); \
                *(unsigned*)(tb + ((size_t)(2 * (4 * j + q) + (lane >> 5)) * 16384 + row) * 128 + 4 * (lane & 31)) = (unsigned)p; }     \
        if (lane == 0) (second ? vsc : usc)[row] = inv; \
        if (!second) { float d[4] = {0.f, 0.f, 0.f, 0.f};                        \
            _Pragma("unroll") for (int j = 0; j < 2; ++j) _Pragma("unroll") for (int q = 0; q < 4; ++q) _Pragma("unroll") for (int b = 0; b < 4; ++b) { const f32x4 s4 = *(const f32x4*)(sh2 + b * DM + 256 * (4 * j + q) + 4 * lane); \
                d[b] += V[j][q][0] * s4[0] + V[j][q][1] * s4[1] + V[j][q][2] * s4[2] + V[j][q][3] * s4[3]; } \
            _Pragma("unroll") for (int b = 0; b < 4; ++b) { const float t = wave_sum(d[b]); if (lane == 0) ush[b * 16384 + row] = t; } } } while (0)
#define TB_ROW(q_) (8 * (gw + ((q_) >> 3) * NGW) + ((q_) & 7))
    f32x4 va[2][4], vb2[2][4];
    TB_LOAD(va, TB_ROW(0));
#pragma unroll 1
    for (int q = 0; TB_ROW(q) < 2 * 16384; q += 2) { const int ra = TB_ROW(q), rb = TB_ROW(q + 1);
        TB_LOAD(vb2, rb);
        TB_STORE(va, ra);
        TB_LOAD(va, TB_ROW(q + 2));
        TB_STORE(vb2, rb); }
#undef TB_ROW
#undef TB_LOAD
#undef TB_STORE
}

__device__ __forceinline__ void phase_kpe(const int tid, const Args& a) {
    const int gt = blockIdx.x * NTHREADS + tid, NGT = gridDim.x * NTHREADS;
    const bf16_t* proj = (const bf16_t*)(a.ws + WS_PROJ); const f32x2* cs = (const f32x2*)(a.ws + WS_CS); unsigned short* kp = (unsigned short*)(a.ws + WS_KPE);
    for (int i = gt; i < NTOK * 32; i += NGT) { const int tok = i >> 5, fi = i & 31; const unsigned w = *(const unsigned*)(proj + (size_t)tok * NPROJ + PJ_KPE + 2 * fi);
        const float x1 = bf_lo(w), x2 = bf_hi(w); const f32x2 c = cs[i]; kp[i] = (unsigned short)(pk4_fp8(x1 * c[0] - x2 * c[1], x2 * c[0] + x1 * c[1], 0.f, 0.f, FP8_SK) & 0xffffu); }
}

__device__ __forceinline__ bf16x8 ldsfrag(const char* base, int row, int ldb_bytes, int kbyte) { return *(const bf16x8*)(base + row * ldb_bytes + kbyte); }

namespace gla {
constexpr int L_BC = 0, L_SEG = 32768, L_GLR = 34816;
constexpr int A_KDT = 38912, A_VT = 57344;
constexpr int C_QE = 38912, C_KE = 56320, C_QB = 73728, C_VT = 91136, C_AM = 128000, C_PART = 137216, C_RS = 139264;
constexpr int LD72 = 144, LD136 = 272;

__device__ __forceinline__ float logsig(float z) { return fminf(z, 0.f) - log1pf(__expf(-fabsf(z))); }

__device__ __forceinline__ void build_bcum(const int tid, const Args& a, char* lds, const bf16_t* proj, int t0, int hd) {
    float* BC = (float*)(lds + L_BC); float* SEG = (float*)(lds + L_SEG); float* GLR = (float*)(lds + L_GLR);
    { const int idx = tid * 2, i = idx >> 4, r = idx & 15; const unsigned w = *(const unsigned*)(proj + (size_t)(t0 + i) * NPROJ + PJ_GLR + r); GLR[idx] = bf_lo(w); GLR[idx + 1] = bf_hi(w); }
    __syncthreads();
    const int d = tid & 127, iq = tid >> 7;
    float w2r[16];
#pragma unroll
    for (int r = 0; r < 16; ++r) w2r[r] = a.w_gate2[r * 512 + hd * 128 + d];
    const float bg = a.b_gate[hd * 128 + d];
    float run = 0.f;
#pragma unroll 2
    for (int ii = 0; ii < 16; ++ii) { const int i = iq * 16 + ii; float z = bg;
#pragma unroll
        for (int r4 = 0; r4 < 4; ++r4) { const f32x4 gl = *(const f32x4*)(GLR + i * 16 + 4 * r4); z += gl[0] * w2r[4 * r4] + gl[1] * w2r[4 * r4 + 1] + gl[2] * w2r[4 * r4 + 2] + gl[3] * w2r[4 * r4 + 3]; }
        run += logsig(z) * (1.f / 16.f); BC[i * 128 + d] = run; }
    SEG[iq * 128 + d] = run;
    __syncthreads();
    float off = 0.f;
#pragma unroll 1
    for (int q = 0; q < iq; ++q) off += SEG[q * 128 + d];
#pragma unroll 4
    for (int ii = 0; ii < 16; ++ii) BC[(iq * 16 + ii) * 128 + d] += off;
    __syncthreads();
}
__device__ __forceinline__ void build_vt(const int tid, char* lds, int off_vt, const bf16_t* proj, int t0, int hd) {
    const int c = tid & 255, g = tid >> 8;
#pragma unroll
    for (int p = 0; p < 4; ++p) { const int i0 = g * 32 + p * 8; unsigned short e[8];
#pragma unroll
        for (int q = 0; q < 8; ++q) e[q] = proj[(size_t)(t0 + i0 + q) * NPROJ + PJ_GV + hd * 256 + c];
        u32x4 w; w.x = e[0] | ((unsigned)e[1] << 16); w.y = e[2] | ((unsigned)e[3] << 16); w.z = e[4] | ((unsigned)e[5] << 16); w.w = e[6] | ((unsigned)e[7] << 16);
        *(u32x4*)(lds + off_vt + c * LD72 + i0 * 2) = w; }
}

constexpr size_t G_AM = WS_GLAU, G_QB = WS_GLAU + 8 * MiB, G_KDT = WS_GLAU + 24 * MiB, G_VT = WS_GLAU + 40 * MiB, G_ORAW = WS_GLAU + 72 * MiB;
constexpr int P_QE = 38912, P_KE = 56320, P_QB = 73728, P_KDT = 91136, P_VT = 109568, P_AM = 0;

__device__ __forceinline__ void phase_pre(const int tid, const Args& a, char* lds) {
    const int lane = tid & 63, wave = __builtin_amdgcn_readfirstlane(tid >> 6), fr = lane & 15, fq = lane >> 4;
    const bf16_t* proj = (const bf16_t*)(a.ws + WS_PROJ); float* decay = (float*)(a.ws + WS_DECAY);
    bf16_t* AMg = (bf16_t*)(a.ws + G_AM); bf16_t* QBg = (bf16_t*)(a.ws + G_QB); bf16_t* KDTg = (bf16_t*)(a.ws + G_KDT); bf16_t* VTg = (bf16_t*)(a.ws + G_VT);
    unsigned* qh = (unsigned*)(a.ws + WS_CTL + CTL_QUEUE) + 64 * 96; volatile unsigned* qs = (volatile unsigned*)(lds + MISC_OFF_PRE);
    if (tid == 0) qs[0] = __hip_atomic_fetch_add(qh, 1u, __ATOMIC_RELAXED, __HIP_MEMORY_SCOPE_AGENT);
    __syncthreads(); int ch = (int)qs[0]; __syncthreads();
    for (;;) {
        if (ch >= 1024) break;
        unsigned nxt = 0u; if (tid == 0) nxt = __hip_atomic_fetch_add(qh, 1u, __ATOMIC_RELAXED, __HIP_MEMORY_SCOPE_AGENT);
        const int bh = ch >> 6, n = ch & 63, b = bh >> 2, hd = bh & 3, t0 = b * SEQ + n * 64;
        unsigned qraw[16], kraw[16], vraw[32];
        { const int d = tid & 127, g = tid >> 7, c = tid & 255, g2 = tid >> 8;
#pragma unroll
          for (int q = 0; q < 16; ++q) { qraw[q] = proj[(size_t)(t0 + g * 16 + q) * NPROJ + PJ_GQ + hd * 128 + d]; kraw[q] = proj[(size_t)(t0 + g * 16 + q) * NPROJ + PJ_GK + hd * 128 + d]; }
#pragma unroll
          for (int q = 0; q < 32; ++q) vraw[q] = proj[(size_t)(t0 + g2 * 32 + q) * NPROJ + PJ_GV + hd * 256 + c]; }
        __builtin_amdgcn_sched_barrier(0);
        build_bcum(tid, a, lds, proj, t0, hd);
        const float* BC = (const float*)(lds + L_BC);
        { const int d = tid & 127, g = tid >> 7; const float bmid = BC[31 * 128 + d], blast = BC[63 * 128 + d];
          bf16_t* QE = (bf16_t*)(lds + P_QE); bf16_t* KE = (bf16_t*)(lds + P_KE); bf16_t* QB = (bf16_t*)(lds + P_QB);
          if (g == 0) decay[ch * 128 + d] = __expf(blast);
#pragma unroll
          for (int p = 0; p < 2; ++p) { float kd[8];
#pragma unroll
            for (int q = 0; q < 8; ++q) { const int i = g * 16 + p * 8 + q; const float bc = BC[i * 128 + d];
                const float qv = __uint_as_float(qraw[p * 8 + q] << 16) * GLA_QS, kv = __uint_as_float(kraw[p * 8 + q] << 16);
                QE[i * 136 + d] = f2bf(qv * __expf(bc - bmid)); KE[i * 136 + d] = f2bf(kv * __expf(bmid - bc)); QB[i * 136 + d] = f2bf(qv * __expf(bc)); kd[q] = kv * __expf(blast - bc); }
            u32x4 w; w.x = cvt_pk_bf16(kd[0], kd[1]); w.y = cvt_pk_bf16(kd[2], kd[3]); w.z = cvt_pk_bf16(kd[4], kd[5]); w.w = cvt_pk_bf16(kd[6], kd[7]);
            *(u32x4*)(lds + P_KDT + d * LD72 + (g * 16 + p * 8) * 2) = w; } }
        { const int c = tid & 255, g2 = tid >> 8;
#pragma unroll
          for (int p = 0; p < 4; ++p) { u32x4 w; w.x = vraw[8 * p] | (vraw[8 * p + 1] << 16); w.y = vraw[8 * p + 2] | (vraw[8 * p + 3] << 16); w.z = vraw[8 * p + 4] | (vraw[8 * p + 5] << 16); w.w = vraw[8 * p + 6] | (vraw[8 * p + 7] << 16);
              *(u32x4*)(lds + P_VT + c * LD72 + (g2 * 32 + p * 8) * 2) = w; } }
        __syncthreads();
        { const int jt = wave & 3;
#pragma unroll
          for (int il = 0; il < 2; ++il) { const int it = (wave >> 2) * 2 + il; f32x4 acc = {0.f, 0.f, 0.f, 0.f};
#pragma unroll
            for (int ks = 0; ks < 4; ++ks) acc = __builtin_amdgcn_mfma_f32_16x16x32_bf16(ldsfrag(lds + P_KE, jt * 16 + fr, LD136, ks * 64 + fq * 16), ldsfrag(lds + P_QE, it * 16 + fr, LD136, ks * 64 + fq * 16), acc, 0, 0, 0);
            const int i = it * 16 + fr, j0 = jt * 16 + 4 * fq;
            u32x2 w; w.x = cvt_pk_bf16(j0 <= i ? acc[0] : 0.f, j0 + 1 <= i ? acc[1] : 0.f); w.y = cvt_pk_bf16(j0 + 2 <= i ? acc[2] : 0.f, j0 + 3 <= i ? acc[3] : 0.f);
            *(u32x2*)(lds + P_AM + i * LD72 + j0 * 2) = w; } }
        __syncthreads();
        { const int row = tid >> 3, c16 = tid & 7; *(u32x4*)(AMg + (size_t)ch * 4096 + row * 64 + c16 * 8) = *(const u32x4*)(lds + P_AM + row * LD72 + c16 * 16); }
#pragma unroll
        for (int k = 0; k < 2; ++k) { const int idx = tid + 512 * k;
            { const int row = idx >> 4, c16 = idx & 15; *(u32x4*)(QBg + (size_t)ch * 8192 + row * 128 + c16 * 8) = *(const u32x4*)(lds + P_QB + row * LD136 + c16 * 16); }
            { const int row = idx >> 3, c16 = idx & 7; *(u32x4*)(KDTg + (size_t)ch * 8192 + row * 64 + c16 * 8) = *(const u32x4*)(lds + P_KDT + row * LD72 + c16 * 16); } }
#pragma unroll
        for (int k = 0; k < 4; ++k) { const int idx = tid + 512 * k, row = idx >> 3, c16 = idx & 7; *(u32x4*)(VTg + (size_t)ch * 16384 + row * 64 + c16 * 8) = *(const u32x4*)(lds + P_VT + row * LD72 + c16 * 16); }
        if (tid == 0) qs[0] = nxt;
        __syncthreads(); ch = (int)qs[0]; __syncthreads(); }
}

constexpr int Q_AM = 0, Q_QB = 9216, Q_KDT = 26624, Q_VT = 45056, Q_ST = 63488, Q_DEC = 98304;
__device__ __forceinline__ void phase_seq(const int tid, const Args& a, char* lds) {
    const int lane = tid & 63, wave = __builtin_amdgcn_readfirstlane(tid >> 6), fr = lane & 15, fq = lane >> 4;
    const float* decay = (const float*)(a.ws + WS_DECAY); bf16_t* oraw = (bf16_t*)(a.ws + G_ORAW);
    const bf16_t* AMg = (const bf16_t*)(a.ws + G_AM); const bf16_t* QBg = (const bf16_t*)(a.ws + G_QB); const bf16_t* KDTg = (const bf16_t*)(a.ws + G_KDT); const bf16_t* VTg = (const bf16_t*)(a.ws + G_VT);
    for (int item = blockIdx.x; item < 32; item += gridDim.x) { const int bh = item >> 1, hs = item & 1, b = bh >> 2, hd = bh & 3;
        f32x4 accS[8];
#pragma unroll
        for (int dt = 0; dt < 8; ++dt) accS[dt] = (f32x4){0.f, 0.f, 0.f, 0.f};
        u32x2 zz; asm volatile("v_mov_b32 %0, 0\n\tv_mov_b32 %1, 0" : "=v"(zz.x), "=v"(zz.y));
#pragma unroll
        for (int dt = 0; dt < 8; ++dt) *(u32x2*)(lds + Q_ST + (16 * wave + fr) * LD136 + (16 * dt + 4 * fq) * 2) = zz;
        u32x4 ram[2], rqb[2][2], rkd[2][2], rvt[2][2]; f32x4 rdc[2];
#define SQ_LOAD(S_, n_) do { const size_t ch_ = (size_t)bh * 64 + (n_); { const int row = tid >> 3, c16 = tid & 7; ram[S_] = *(const u32x4*)(AMg + ch_ * 4096 + row * 64 + c16 * 8); } \
        _Pragma("unroll") for (int k = 0; k < 2; ++k) { const int idx = tid + 512 * k; rqb[S_][k] = *(const u32x4*)(QBg + ch_ * 8192 + (idx >> 4) * 128 + (idx & 15) * 8); rkd[S_][k] = *(const u32x4*)(KDTg + ch_ * 8192 + (idx >> 3) * 64 + (idx & 7) * 8); \
            rvt[S_][k] = *(const u32x4*)(VTg + ch_ * 16384 + (hs * 128 + (idx >> 3)) * 64 + (idx & 7) * 8); } \
        if (tid < 32) rdc[S_] = *(const f32x4*)(decay + ch_ * 128 + 4 * tid); } while (0)
#define SQ_WRITE(S_) do { { const int row = tid >> 3, c16 = tid & 7; *(u32x4*)(lds + Q_AM + row * LD72 + c16 * 16) = ram[S_]; } \
        _Pragma("unroll") for (int k = 0; k < 2; ++k) { const int idx = tid + 512 * k; *(u32x4*)(lds + Q_QB + (idx >> 4) * LD136 + (idx & 15) * 16) = rqb[S_][k]; *(u32x4*)(lds + Q_KDT + (idx >> 3) * LD72 + (idx & 7) * 16) = rkd[S_][k]; \
            *(u32x4*)(lds + Q_VT + (idx >> 3) * LD72 + (idx & 7) * 16) = rvt[S_][k]; } \
        if (tid < 32) *(f32x4*)(lds + Q_DEC + 16 * tid) = rdc[S_]; } while (0)
#define SQ_STEP(n_, SL_, SW_) do { const int n = (n_); \
            SQ_LOAD(SL_, (n + 2 < 64 ? n + 2 : n));                                                            \
            const int crow = 16 * wave + fr;                                                                   \
            const bf16x8 v0 = ldsfrag(lds + Q_VT, crow, LD72, fq * 16), v1 = ldsfrag(lds + Q_VT, crow, LD72, 64 + fq * 16); \
            bf16x8 sf[4]; \
            _Pragma("unroll") for (int ks = 0; ks < 4; ++ks) sf[ks] = ldsfrag(lds + Q_ST, crow, LD136, ks * 64 + fq * 16); \
            _Pragma("unroll") for (int it = 0; it < 4; ++it) { f32x4 acc = {0.f, 0.f, 0.f, 0.f}; const int irow = 16 * it + fr;     \
                acc = __builtin_amdgcn_mfma_f32_16x16x32_bf16(v0, ldsfrag(lds + Q_AM, irow, LD72, fq * 16), acc, 0, 0, 0); \
                acc = __builtin_amdgcn_mfma_f32_16x16x32_bf16(v1, ldsfrag(lds + Q_AM, irow, LD72, 64 + fq * 16), acc, 0, 0, 0); \
                _Pragma("unroll") for (int ks = 0; ks < 4; ++ks) acc = __builtin_amdgcn_mfma_f32_16x16x32_bf16(sf[ks], ldsfrag(lds + Q_QB, irow, LD136, ks * 64 + fq * 16), acc, 0, 0, 0); \
                u32x2 w; w.x = cvt_pk_bf16(acc[0], acc[1]); w.y = cvt_pk_bf16(acc[2], acc[3]); \
                *(u32x2*)(oraw + (size_t)(b * SEQ + n * 64 + irow) * 1024 + hd * 256 + hs * 128 + 16 * wave + 4 * fq) = w; } \
            _Pragma("unroll") for (int dt = 0; dt < 8; ++dt) { const f32x4 dec = *(const f32x4*)(lds + Q_DEC + (16 * dt + 4 * fq) * 4);     \
                accS[dt] = accS[dt] * dec; \
                accS[dt] = __builtin_amdgcn_mfma_f32_16x16x32_bf16(ldsfrag(lds + Q_KDT, 16 * dt + fr, LD72, fq * 16), v0, accS[dt], 0, 0, 0); \
                accS[dt] = __builtin_amdgcn_mfma_f32_16x16x32_bf16(ldsfrag(lds + Q_KDT, 16 * dt + fr, LD72, 64 + fq * 16), v1, accS[dt], 0, 0, 0); } \
            __syncthreads();                                                                                   \
            _Pragma("unroll") for (int dt = 0; dt < 8; ++dt) { u32x2 w; w.x = cvt_pk_bf16(accS[dt][0], accS[dt][1]); w.y = cvt_pk_bf16(accS[dt][2], accS[dt][3]); *(u32x2*)(lds + Q_ST + crow * LD136 + (16 * dt + 4 * fq) * 2) = w; } \
            if (n + 1 < 64) SQ_WRITE(SW_); \
            __syncthreads(); } while (0)
        SQ_LOAD(0, 0); SQ_WRITE(0);
        __syncthreads();
        SQ_LOAD(0, 1);
#pragma unroll 1
        for (int n2 = 0; n2 < 64; n2 += 2) { SQ_STEP(n2, 1, 0); SQ_STEP(n2 + 1, 0, 1); }
#undef SQ_STEP
#undef SQ_LOAD
#undef SQ_WRITE
    }
}
__device__ __forceinline__ void phase_post(const int tid, const Args& a) {
    const int lane = tid & 63, gw = blockIdx.x * NWAVES + __builtin_amdgcn_readfirstlane(tid >> 6), NGW = gridDim.x * NWAVES;
    const bf16_t* oraw = (const bf16_t*)(a.ws + G_ORAW); const bf16_t* proj = (const bf16_t*)(a.ws + WS_PROJ); bf16_t* mix = (bf16_t*)(a.ws + WS_HBUF);
    constexpr int NB = 8;
    for (int it0 = gw * NB; it0 < NTOK * 4; it0 += NGW * NB) { u32x2 ow[NB], gw2[NB];
#pragma unroll
        for (int k = 0; k < NB; ++k) { const int it = it0 + k, tok = it >> 2, c = (it & 3) * 256 + 4 * lane;
            ow[k] = __builtin_nontemporal_load((const u32x2*)(oraw + (size_t)tok * 1024 + c)); gw2[k] = __builtin_nontemporal_load((const u32x2*)(proj + (size_t)tok * NPROJ + PJ_GR + c)); }
#pragma unroll
        for (int k = 0; k < NB; ++k) { const int it = it0 + k, tok = it >> 2, c = (it & 3) * 256 + 4 * lane; const f32x4 g4 = *(const f32x4*)(a.gla_og + c);
            const float o0 = bf_lo(ow[k].x), o1 = bf_hi(ow[k].x), o2 = bf_lo(ow[k].y), o3 = bf_hi(ow[k].y);
            const float rs = rsqrtf(wave_sum(o0 * o0 + o1 * o1 + o2 * o2 + o3 * o3) * (1.f / 256.f) + EPS);
            const float g0 = bf_lo(gw2[k].x), g1 = bf_hi(gw2[k].x), g2 = bf_lo(gw2[k].y), g3 = bf_hi(gw2[k].y);
            *(unsigned*)((unsigned char*)mix + (size_t)tok * DM + 1024 + c) = pk4_fp8(o0 * rs * g4[0] * (g0 / (1.f + __expf(-g0))), o1 * rs * g4[1] * (g1 / (1.f + __expf(-g1))),
                                                                                       o2 * rs * g4[2] * (g2 / (1.f + __expf(-g2))), o3 * rs * g4[3] * (g3 / (1.f + __expf(-g3))), FP8_SA); } }
}
}

namespace att {
constexpr int KROW = 208, SHM_K = 64 * KROW, VTROW = 80, SHM_V = 128 * VTROW;
constexpr int L_V = 0, L_K = 2 * SHM_V, L_WS = L_K + 2 * SHM_K;
#define SBAR() __builtin_amdgcn_sched_barrier(0)
__device__ __forceinline__ int v_st(int k, int c) { const int kk = (k & ~0xC) | ((k & 4) << 1) | ((k & 8) >> 1); return ((kk >> 3) * 4 + (c >> 5)) * 512 + ((kk & 7) * 32 + (c & 31)) * 2; }
__device__ __forceinline__ int v_rd_base(int lane) { return ((lane & 3) << 3) | (((lane >> 2) & 3) << 6) | (((lane >> 4) & 1) << 5) | (((lane >> 5) & 1) << 8); }
constexpr int v_rd_off(int d0, int ks, int half) { return d0 * 512 + ks * 4096 + half * 2048; }
__device__ __forceinline__ int crow(int r, int hi) { return (r & 3) + 8 * (r >> 2) + 4 * hi; }

__device__ __forceinline__ void pv_tile(f32x16* o, int vb, bf16x8 pa0, bf16x8 pa1, bf16x8 pa2, bf16x8 pa3) {
#define TRRD(dst, off) asm volatile("ds_read_b64_tr_b16 %0, %1 offset:%2" : "=&v"(dst) : "v"(vb), "i"(off) : "memory")
#define PV_D0(d0) do { s16x4 l0, l1, l2, l3, h0, h1, h2, h3; constexpr int b_ = v_rd_off(d0, 0, 0); \
        TRRD(l0, b_); TRRD(h0, b_ + 2048); TRRD(l1, b_ + 4096); TRRD(h1, b_ + 6144); TRRD(l2, b_ + 8192); TRRD(h2, b_ + 10240); TRRD(l3, b_ + 12288); TRRD(h3, b_ + 14336); \
        asm volatile("s_waitcnt lgkmcnt(0)" ::: "memory"); SBAR(); \
        o[d0] = __builtin_amdgcn_mfma_f32_32x32x16_bf16(pa0, (bf16x8){l0[0], l0[1], l0[2], l0[3], h0[0], h0[1], h0[2], h0[3]}, o[d0], 0, 0, 0); \
        o[d0] = __builtin_amdgcn_mfma_f32_32x32x16_bf16(pa1, (bf16x8){l1[0], l1[1], l1[2], l1[3], h1[0], h1[1], h1[2], h1[3]}, o[d0], 0, 0, 0); \
        o[d0] = __builtin_amdgcn_mfma_f32_32x32x16_bf16(pa2, (bf16x8){l2[0], l2[1], l2[2], l2[3], h2[0], h2[1], h2[2], h2[3]}, o[d0], 0, 0, 0); \
        o[d0] = __builtin_amdgcn_mfma_f32_32x32x16_bf16(pa3, (bf16x8){l3[0], l3[1], l3[2], l3[3], h3[0], h3[1], h3[2], h3[3]}, o[d0], 0, 0, 0); } while (0)
    PV_D0(0); PV_D0(1); PV_D0(2); PV_D0(3);
#undef PV_D0
#undef TRRD
}

__device__ __forceinline__ void attn_block(const int wave_s, const Args& a, char* lds, int b, int h, int qb) {
    int tid; asm volatile("v_mbcnt_lo_u32_b32 %0, -1, 0\n\tv_mbcnt_hi_u32_b32 %0, -1, %0" : "=v"(tid)); tid |= wave_s << 6;
    float l_reg = 0.f; f32x16 o[4] = {};
    const int tok0 = b * SEQ;
    bf16_t* mix = (bf16_t*)(a.ws + WS_HBUF);
    {
    const int wid = __builtin_amdgcn_readfirstlane(tid >> 6), lane = tid & 63, r32 = lane & 31, hi = lane >> 5;
    const unsigned char* Q8 = a.ws + WS_QMLA; const unsigned char* K8 = a.ws + WS_K8; const unsigned char* VT8 = a.ws + WS_VT8; const unsigned char* PE8 = a.ws + WS_KPE;
    const int q0 = qb * 256, NT = (q0 + 256) / 64, qlo = q0 + wid * 32, qm = qlo + r32 - 4 * hi;
    char* V_lds = lds + L_V; char* K_lds = lds + L_K;
    i32x8v qf[3];
    { const unsigned char* qp = Q8 + (size_t)(tok0 + qlo + r32) * 1536 + h * 192 + 32 * hi;
#pragma unroll
      for (int st = 0; st < 3; ++st) { const i32x4v lo_ = *(const i32x4v*)(qp + 64 * st), hi_ = *(const i32x4v*)(qp + 64 * st + 16); qf[st] = __builtin_shufflevector(lo_, hi_, 0, 1, 2, 3, 4, 5, 6, 7); } }
#pragma unroll
    for (int st = 0; st < 3; ++st) asm volatile("" : "+v"(qf[st]));
    const int kkey = tid >> 3, kpart = tid & 7, rkey = (tid & 255) >> 2, rpart = tid & 3, vcol = tid >> 2, vpart = tid & 3;
    const int kdst = kkey * KROW + 16 * kpart, rdst = rkey * KROW + 128 + 16 * rpart, vdst = vcol * VTROW + 16 * vpart;
    const unsigned kofs = (unsigned)(kkey * 1024 + 16 * kpart), pofs = (unsigned)(rkey * 64 + 16 * rpart), vofs = (unsigned)(vcol * NTOK + 16 * vpart);
    i32x4v sk[2], sr[2], sv[2];
#define SLOAD(S_, kb) do { const unsigned char* kb_ = K8 + (size_t)(tok0 + (kb)) * 1024 + h * 128; const unsigned char* pb_ = PE8 + (size_t)(tok0 + (kb)) * 64; const unsigned char* vb_ = VT8 + (size_t)(h * 128) * NTOK + tok0 + (kb); \
        sk[S_] = *(const i32x4v*)(kb_ + kofs); sr[S_] = *(const i32x4v*)(pb_ + pofs); sv[S_] = *(const i32x4v*)(vb_ + vofs); } while (0)
#define SWRITE(S_, bf) do { *(i32x4v*)(K_lds + (bf) * SHM_K + kdst) = sk[S_]; if (tid < 256) *(i32x4v*)(K_lds + (bf) * SHM_K + rdst) = sr[S_]; *(i32x4v*)(V_lds + (bf) * SHM_V + vdst) = sv[S_]; } while (0)
    float m_reg = -1e30f;
    constexpr float SCI = 1.f / (FP8_SQ * FP8_SK);
#define LD32(P_) ({ const i32x4v lo_ = *(const i32x4v*)(P_), hi_ = *(const i32x4v*)((P_) + 16); __builtin_shufflevector(lo_, hi_, 0, 1, 2, 3, 4, 5, 6, 7); })
#define MFMA8(ACC, A_, B_) asm volatile("v_mfma_f32_32x32x64_f8f6f4 %0, %1, %2, %0" : "+v"(ACC) : "v"(A_), "v"(B_))
#define PK4F(P, B_) ({ int p_ = __builtin_amdgcn_cvt_pk_fp8_f32(P[(B_) + 0], P[(B_) + 1], 0, false); p_ = __builtin_amdgcn_cvt_pk_fp8_f32(P[(B_) + 2], P[(B_) + 3], p_, true); (unsigned)p_; })
#define ASTEP(t_, SL_, SW_) do { const int t = (t_), bf = t & 1, kb = t * 64; \
        SLOAD(SL_, (t + 2 < NT ? kb + 128 : kb));                               \
        if (t + 1 < NT) SWRITE(SW_, bf ^ 1);                                     \
        if (kb <= qlo + 31) {                                                    \
        f32x16 p0 = {}, p1 = {}; \
        { const char* kp = K_lds + bf * SHM_K + r32 * KROW + 32 * hi; __builtin_amdgcn_s_setprio(1); \
          _Pragma("unroll") for (int st = 0; st < 3; ++st) { const i32x8v k0 = LD32(kp + 64 * st), k1 = LD32(kp + 64 * st + 32 * KROW); MFMA8(p0, k0, qf[st]); MFMA8(p1, k1, qf[st]); } \
          __builtin_amdgcn_s_setprio(0); asm volatile("s_nop 15\n\ts_nop 7" ::: "memory"); }     \
        if (kb + 63 > qlo) { const float NEG = -__builtin_inff(); const int dq = qm - kb; \
            _Pragma("unroll") for (int r = 0; r < 16; ++r) { const int c = (r & 3) + 8 * (r >> 2); if (dq - c < 0) p0[r] = NEG; if (dq - c - 32 < 0) p1[r] = NEG; } } \
        float pmax = p0[0]; \
        _Pragma("unroll") for (int r = 1; r < 16; ++r) pmax = fmaxf(pmax, p0[r]); \
        _Pragma("unroll") for (int r = 0; r < 16; ++r) pmax = fmaxf(pmax, p1[r]); \
        { auto rr = __builtin_amdgcn_permlane32_swap(__float_as_uint(pmax), __float_as_uint(pmax), false, false); pmax = fmaxf(__uint_as_float(rr[0]), __uint_as_float(rr[1])); } \
        pmax *= SCI; \
        float mn = m_reg, alpha = 1.f; \
        if (!__all(pmax - m_reg <= 8.f)) { mn = fmaxf(m_reg, pmax); alpha = __builtin_amdgcn_exp2f(m_reg - mn); m_reg = mn; }     \
        float ps = 0.f; \
        _Pragma("unroll") for (int r = 0; r < 16; ++r) { p0[r] = __builtin_amdgcn_exp2f(__builtin_fmaf(p0[r], SCI, -mn)); p1[r] = __builtin_amdgcn_exp2f(__builtin_fmaf(p1[r], SCI, -mn)); ps += p0[r] + p1[r]; } \
        { auto rr = __builtin_amdgcn_permlane32_swap(__float_as_uint(ps), __float_as_uint(ps), false, false); ps = __uint_as_float(rr[0]) + __uint_as_float(rr[1]); } \
        l_reg = l_reg * alpha + ps; \
        if (__any(alpha < 1.f)) { int r32o = r32, hio = hi; asm volatile("" : "+v"(r32o), "+v"(hio)); float* al_l = (float*)(lds + L_WS) + wid * 64 + 32; if (hio == 0) al_l[r32o] = alpha; asm volatile("s_waitcnt lgkmcnt(0)" ::: "memory"); __builtin_amdgcn_wave_barrier(); \
            _Pragma("unroll") for (int r = 0; r < 16; ++r) { const float f = al_l[crow(r, hio)]; \
                _Pragma("unroll") for (int d_ = 0; d_ < 4; ++d_) o[d_][r] *= f; } } \
          \
        i32x8v pa; \
        _Pragma("unroll") for (int i = 0; i < 4; ++i) { auto rr = __builtin_amdgcn_permlane32_swap(PK4F(p0, 4 * i), PK4F(p1, 4 * i), false, false); pa[2 * i] = (int)rr[0]; pa[2 * i + 1] = (int)rr[1]; } \
        { const char* vp = V_lds + bf * SHM_V + r32 * VTROW + 32 * hi; __builtin_amdgcn_s_setprio(1); \
          _Pragma("unroll") for (int d0 = 0; d0 < 4; ++d0) { const i32x8v vf = LD32(vp + d0 * 32 * VTROW); MFMA8(o[d0], pa, vf); } \
          __builtin_amdgcn_s_setprio(0); } } \
        __syncthreads(); } while (0)
    SLOAD(0, 0); SWRITE(0, 0);
    SLOAD(1, 64);
    __syncthreads();
#pragma unroll 1
    for (int t2 = 0; t2 < NT; t2 += 2) { ASTEP(t2, 0, 1); ASTEP(t2 + 1, 1, 0); }
    asm volatile("s_nop 15\n\ts_nop 7" ::: "memory");
#undef ASTEP
#undef LD32
#undef MFMA8
#undef PK4F
#undef SLOAD
#undef SWRITE
    }
    int tid3; asm volatile("v_mbcnt_lo_u32_b32 %0, -1, 0\n\tv_mbcnt_hi_u32_b32 %0, -1, %0" : "=v"(tid3)); tid3 |= wave_s << 6;
    const int wid3 = __builtin_amdgcn_readfirstlane(tid3 >> 6), r32 = tid3 & 31, hi = (tid3 >> 5) & 1, qlo = qb * 256 + wid3 * 32;
    float* li_l = (float*)(lds + L_WS) + wid3 * 64;
    if (hi == 0) li_l[r32] = l_reg; asm volatile("s_waitcnt lgkmcnt(0)" ::: "memory"); __builtin_amdgcn_wave_barrier();
    float g4[4];
#pragma unroll
    for (int d0 = 0; d0 < 4; ++d0) g4[d0] = a.mla_og[h * 128 + d0 * 32 + r32];
#pragma unroll
    for (int r = 0; r < 16; ++r) { const float rl = __builtin_amdgcn_rcpf(li_l[crow(r, hi)]); float ss = 0.f;
#pragma unroll
        for (int d0 = 0; d0 < 4; ++d0) { o[d0][r] *= rl * (1.f / FP8_SK); ss += o[d0][r] * o[d0][r]; }
        ss += __shfl_xor(ss, 1); ss += __shfl_xor(ss, 2); ss += __shfl_xor(ss, 4); ss += __shfl_xor(ss, 8); ss += __shfl_xor(ss, 16);
        const float rs = rsqrtf(ss * (1.f / 128.f) + EPS);
        unsigned char* orow = (unsigned char*)mix + (size_t)(tok0 + qlo + crow(r, hi)) * DM + h * 128;
#pragma unroll
        for (int d0 = 0; d0 < 4; ++d0) { const float v = __builtin_amdgcn_fmed3f(o[d0][r] * rs * g4[d0] * FP8_SA, -448.f, 448.f);
            orow[d0 * 32 + r32] = (unsigned char)(__builtin_amdgcn_cvt_pk_fp8_f32(v, 0.f, 0, false) & 0xff); } }
    __syncthreads();
}
#undef SBAR
}

namespace peer {
__device__ __forceinline__ f32x2 fp8lo(unsigned w) { return __builtin_amdgcn_cvt_pk_f32_fp8((int)w, false); }
__device__ __forceinline__ f32x2 fp8hi(unsigned w) { return __builtin_amdgcn_cvt_pk_f32_fp8((int)w, true); }
struct UIds { u32x4 e[2]; u32x4 h0, h1; };
#define XID16(E, i) ((E[(i) >> 3][((i) >> 1) & 3] >> (16 * ((i) & 1))) & 0xffffu)
constexpr int PEER_CH = 8, PEER_NCH = NTOK / PEER_CH;
struct TokGen { unsigned* qh; int c, p, cn, lane;
    __device__ __forceinline__ int grab() { unsigned v = 0u; if (lane == 0) v = __hip_atomic_fetch_add(qh, 1u, __ATOMIC_RELAXED, __HIP_MEMORY_SCOPE_AGENT); return (int)__builtin_amdgcn_readfirstlane(v); }
    __device__ __forceinline__ void init(unsigned* q, int ln) { qh = q; lane = ln; p = 0; c = grab(); cn = grab(); }
    __device__ __forceinline__ int next() { if (c >= PEER_NCH) return -1; const int t = c * PEER_CH + p; if (++p == PEER_CH) { p = 0; c = cn; cn = grab(); } return t; }
};
__device__ __forceinline__ void phase_u(const int tid, const Args& a) {
    const int lane = tid & 63, g8 = lane >> 3, l8 = lane & 7;
    const int grp = blockIdx.x & 7;
    const bf16_t* h2 = (const bf16_t*)(a.ws + WS_Y); const unsigned short* exp16 = (const unsigned short*)(a.ws + WS_EXP16); bf16_t* part = (bf16_t*)(a.ws + WS_PART);
#define U_LOAD_IDS(I, t_) do { const int t = (t_); \
        _Pragma("unroll") for (int c = 0; c < 2; ++c) I.e[c] = *(const u32x4*)(exp16 + (size_t)t * 128 + 16 * g8 + 8 * c); \
        I.h0 = __builtin_nontemporal_load((const u32x4*)(h2 + (size_t)t * DM + sl * 128 + 16 * l8)); I.h1 = __builtin_nontemporal_load((const u32x4*)(h2 + (size_t)t * DM + sl * 128 + 16 * l8 + 8)); } while (0)
#define U_LOAD_TAB(W, I) do { _Pragma("unroll") for (int i = 0; i < 16; ++i) W[i] = *(const u32x4*)(T + (size_t)XID16(I.e, i) * 128); } while (0)
#define PU_LEVEL(NH, ST, BIT, XF) _Pragma("unroll") for (int j = 0; j < (NH); ++j) { const bool up = (lane >> (BIT)) & 1; const float keep = up ? p[j + (ST)] : p[j], send = up ? p[j] : p[j + (ST)]; p[j] = keep + XF(send); }
#define U_COMPUTE(W, I, t_) do { f32x2 h[8]; \
        _Pragma("unroll") for (int k = 0; k < 4; ++k) { h[k] = (f32x2){bf_lo(I.h0[k]), bf_hi(I.h0[k])}; h[4 + k] = (f32x2){bf_lo(I.h1[k]), bf_hi(I.h1[k])}; } \
        float p[16]; \
        _Pragma("unroll") for (int i = 0; i < 16; ++i) { f32x2 d = fp8lo(W[i][0]) * h[0] + fp8hi(W[i][0]) * h[1]; \
            d += fp8lo(W[i][1]) * h[2] + fp8hi(W[i][1]) * h[3]; d += fp8lo(W[i][2]) * h[4] + fp8hi(W[i][2]) * h[5]; d += fp8lo(W[i][3]) * h[6] + fp8hi(W[i][3]) * h[7]; p[i] = d[0] + d[1]; } \
        PU_LEVEL(8, 8, 2, lx7) PU_LEVEL(4, 4, 1, lx2) PU_LEVEL(2, 2, 0, lx1) \
        bf16_t* pp = part + ((size_t)sl * NTOK + (t_)) * 128 + 16 * g8 + 2 * l8; *(unsigned*)pp = cvt_pk_bf16(p[0], p[1]); } while (0)
    for (int sp = 0; sp < 2; ++sp) { const int sl = 2 * grp + sp; const unsigned char* T = a.ws + WS_UTAB + (size_t)sl * 16384 * 128 + 16 * l8;
        TokGen tg; tg.init((unsigned*)(a.ws + WS_CTL + CTL_QUEUE) + 64 * (16 + sl), lane);
        int t0 = tg.next(); if (t0 < 0) continue;
        int t1 = tg.next();
        UIds IA, IB, IC, ID; u32x4 WA[16], WB[16];
        U_LOAD_IDS(IA, t0); U_LOAD_IDS(IB, t1 >= 0 ? t1 : t0);
        U_LOAD_TAB(WA, IA);
#pragma unroll 1
        for (;;) { const int t2 = t1 >= 0 ? tg.next() : -1, t3 = t2 >= 0 ? tg.next() : -1;
            U_LOAD_TAB(WB, IB);
            U_LOAD_IDS(IC, t2 >= 0 ? t2 : t0);
            U_COMPUTE(WA, IA, t0);
            U_LOAD_TAB(WA, IC);
            U_LOAD_IDS(ID, t3 >= 0 ? t3 : t0);
            if (t1 >= 0) U_COMPUTE(WB, IB, t1);
            if (t2 < 0) break;
            IA = IC; IB = ID; t0 = t2; t1 = t3; } }
#undef PU_LEVEL
#undef U_COMPUTE
#undef U_LOAD_TAB
#undef U_LOAD_IDS
}
__device__ __forceinline__ void phase_w(const int tid, const Args& a) {
    const bf16_t* part = (const bf16_t*)(a.ws + WS_PART); const int* experts = (const int*)(a.ws + WS_EXPERTS); const float* gates = (const float*)(a.ws + WS_GATES); bf16_t* wts = (bf16_t*)(a.ws + WS_WTS);
    const float* usc = (const float*)(a.ws + WS_USC); const float* vsc = (const float*)(a.ws + WS_VSC); const float* ush = (const float*)(a.ws + WS_USH); const u64* ssx1 = (const u64*)(a.ws + WS_CTL + CTL_SSX1);
    for (int i8 = blockIdx.x * NTHREADS + tid; i8 < NTOK * 16; i8 += gridDim.x * NTHREADS) { const size_t i = 8 * (size_t)i8; float d[8] = {0.f, 0.f, 0.f, 0.f, 0.f, 0.f, 0.f, 0.f};
        u32x4 pw[16];
#pragma unroll
        for (int sl = 0; sl < 16; ++sl) pw[sl] = __builtin_nontemporal_load((const u32x4*)(part + (size_t)sl * NTOK * 128 + i));
        const u32x4 e0 = *(const u32x4*)(experts + i), e1 = *(const u32x4*)(experts + i + 4); const f32x4 g0 = *(const f32x4*)(gates + i), g1 = *(const f32x4*)(gates + i + 4);
        const int t = i8 >> 4; const float rstd = rsqrtf(ss_get(ssx1 + t) * (1.f / DM) + EPS); const float* us = ush + (size_t)(t >> 12) * 16384;
        const unsigned ex[8] = {e0.x, e0.y, e0.z, e0.w, e1.x, e1.y, e1.z, e1.w}; const float g[8] = {g0[0], g0[1], g0[2], g0[3], g1[0], g1[1], g1[2], g1[3]};
        float uc[8], vc[8], hc[8];
#pragma unroll
        for (int k = 0; k < 8; ++k) { uc[k] = usc[ex[k]]; vc[k] = vsc[ex[k]]; hc[k] = us[ex[k]]; }
#pragma unroll
        for (int sl = 0; sl < 16; ++sl) { d[0] += bf_lo(pw[sl].x); d[1] += bf_hi(pw[sl].x); d[2] += bf_lo(pw[sl].y); d[3] += bf_hi(pw[sl].y); d[4] += bf_lo(pw[sl].z); d[5] += bf_hi(pw[sl].z); d[6] += bf_lo(pw[sl].w); d[7] += bf_hi(pw[sl].w); }
        float o[8];
#pragma unroll
        for (int k = 0; k < 8; ++k) { const float dd = d[k] * (uc[k] * rstd) + hc[k]; o[k] = g[k] * vc[k] * 0.5f * dd * (1.f + erff(dd * 0.7071067811865476f)); }
        *(u32x4*)(wts + i) = (u32x4){cvt_pk_bf16(o[0], o[1]), cvt_pk_bf16(o[2], o[3]), cvt_pk_bf16(o[4], o[5]), cvt_pk_bf16(o[6], o[7])}; }
}
struct VIds { u32x4 e[2]; u32x4 w[2]; };
__device__ __forceinline__ void phase_v(const int tid, const Args& a) {
    const int lane = tid & 63, g8 = lane >> 3, l8 = lane & 7;
    const int grp = blockIdx.x & 7;
    const unsigned short* exp16 = (const unsigned short*)(a.ws + WS_EXP16); const bf16_t* wts = (const bf16_t*)(a.ws + WS_WTS); bf16_t* contrib = (bf16_t*)(a.ws + WS_PART);
    const int cl = 16 * l8 + 8 * ((lane >> 5) & 1) + 4 * ((lane >> 4) & 1) + 2 * ((lane >> 3) & 1);
#define V_LOAD_IDS(I, t_) do { const int t = (t_); \
        _Pragma("unroll") for (int c = 0; c < 2; ++c) { I.e[c] = *(const u32x4*)(exp16 + (size_t)t * 128 + 16 * g8 + 8 * c); I.w[c] = *(const u32x4*)(wts + (size_t)t * 128 + 16 * g8 + 8 * c); } } while (0)
#define V_LOAD_TAB(W, I) do { _Pragma("unroll") for (int i = 0; i < 16; ++i) W[i] = *(const u32x4*)(T + (size_t)XID16(I.e, i) * 128); } while (0)
#define PV_LEVEL(NH, ST, BIT, XF) _Pragma("unroll") for (int j = 0; j < (NH); ++j) { const bool up = (lane >> (BIT)) & 1; const float keep = up ? p[j + (ST)] : p[j], send = up ? p[j] : p[j + (ST)]; p[j] = keep + XF; }
#define V_COMPUTE(W, I, t_) do { f32x2 ac[8]; \
        _Pragma("unroll") for (int k = 0; k < 8; ++k) ac[k] = (f32x2){0.f, 0.f}; \
        _Pragma("unroll") for (int i = 0; i < 16; ++i) { const unsigned wp_ = I.w[i >> 3][(i >> 1) & 3]; const float wv = (i & 1) ? bf_hi(wp_) : bf_lo(wp_); const f32x2 w2 = {wv, wv}; \
            _Pragma("unroll") for (int k = 0; k < 4; ++k) { ac[2 * k] += w2 * fp8lo(W[i][k]); ac[2 * k + 1] += w2 * fp8hi(W[i][k]); } } \
        float p[16]; \
        _Pragma("unroll") for (int k = 0; k < 8; ++k) { p[2 * k] = ac[k][0]; p[2 * k + 1] = ac[k][1]; } \
        PV_LEVEL(8, 8, 5, lx32(send, lane)) PV_LEVEL(4, 4, 4, lx16(send, lane)) PV_LEVEL(2, 2, 3, lx8(send)) \
        *(unsigned*)(contrib + (size_t)(t_) * DM + sl * 128 + cl) = cvt_pk_bf16(p[0], p[1]); } while (0)
    for (int sp = 0; sp < 2; ++sp) { const int sl = 2 * grp + sp; const unsigned char* T = a.ws + WS_VTAB + (size_t)sl * 16384 * 128 + 16 * l8;
        TokGen tg; tg.init((unsigned*)(a.ws + WS_CTL + CTL_QUEUE) + 64 * (32 + sl), lane);
        int t0 = tg.next(); if (t0 < 0) continue;
        int t1 = tg.next();
        VIds IA, IB, IC, ID; u32x4 WA[16], WB[16];
        V_LOAD_IDS(IA, t0); V_LOAD_IDS(IB, t1 >= 0 ? t1 : t0);
        V_LOAD_TAB(WA, IA);
#pragma unroll 1
        for (;;) { const int t2 = t1 >= 0 ? tg.next() : -1, t3 = t2 >= 0 ? tg.next() : -1;
            V_LOAD_TAB(WB, IB);
            V_LOAD_IDS(IC, t2 >= 0 ? t2 : t0);
            V_COMPUTE(WA, IA, t0);
            V_LOAD_TAB(WA, IC);
            V_LOAD_IDS(ID, t3 >= 0 ? t3 : t0);
            if (t1 >= 0) V_COMPUTE(WB, IB, t1);
            if (t2 < 0) break;
            IA = IC; IB = ID; t0 = t2; t1 = t3; } }
#undef PV_LEVEL
#undef V_COMPUTE
#undef V_LOAD_TAB
#undef V_LOAD_IDS
}
__device__ __forceinline__ void phase_final(const int tid, const Args& a) {
    const int lane = tid & 63, wave = __builtin_amdgcn_readfirstlane(tid >> 6), gw = blockIdx.x * NWAVES + wave, NGW = gridDim.x * NWAVES;
    const float* modz = (const float*)(a.ws + WS_CTL + CTL_MODZ); const bf16_t* contrib = (const bf16_t*)(a.ws + WS_PART); const bf16_t* x1b = (const bf16_t*)(a.ws + WS_X1);
    for (int grp = gw; grp < NTOK / 8; grp += NGW) { const int row0 = grp * 8, b = row0 >> 12;
        f32x4 g2[8], fg[8];
#pragma unroll
        for (int j = 0; j < 8; ++j) { const int col = 256 * j + 4 * lane; fg[j] = *(const f32x4*)(a.fin_g + col); g2[j] = *(const f32x4*)(modz + (size_t)b * NMOD + MOD_G2 + col) + *(const f32x4*)(a.ada_b + MOD_G2 + col); }
        u32x2 xn[8], cn[8];
#pragma unroll
        for (int j = 0; j < 8; ++j) { xn[j] = __builtin_nontemporal_load((const u32x2*)(x1b + (size_t)row0 * DM + 4 * lane + 256 * j)); cn[j] = __builtin_nontemporal_load((const u32x2*)(contrib + (size_t)row0 * DM + 4 * lane + 256 * j)); }
#pragma unroll 1
        for (int r = 0; r < 8; ++r) { const int row = row0 + r; float* xr = a.out + (size_t)row * DM + 4 * lane;
            f32x4 v[8]; float ss = 0.f; u32x2 xc[8], cc[8];
#pragma unroll
            for (int j = 0; j < 8; ++j) { xc[j] = xn[j]; cc[j] = cn[j]; }
            { const int rn = r + 1 < 8 ? row + 1 : row;
#pragma unroll
              for (int j = 0; j < 8; ++j) { xn[j] = __builtin_nontemporal_load((const u32x2*)(x1b + (size_t)rn * DM + 4 * lane + 256 * j)); cn[j] = __builtin_nontemporal_load((const u32x2*)(contrib + (size_t)rn * DM + 4 * lane + 256 * j)); } }
#pragma unroll
            for (int j = 0; j < 8; ++j) { const u32x2 xw = xc[j]; const u32x2 cw = cc[j];
                v[j][0] = bf_lo(xw.x) + g2[j][0] * bf_lo(cw.x); v[j][1] = bf_hi(xw.x) + g2[j][1] * bf_hi(cw.x); v[j][2] = bf_lo(xw.y) + g2[j][2] * bf_lo(cw.y); v[j][3] = bf_hi(xw.y) + g2[j][3] * bf_hi(cw.y);
                ss += v[j][0] * v[j][0] + v[j][1] * v[j][1] + v[j][2] * v[j][2] + v[j][3] * v[j][3]; }
            const float rstd = rsqrtf(wave_sum(ss) * (1.f / DM) + EPS);
#pragma unroll
            for (int j = 0; j < 8; ++j) __builtin_nontemporal_store(v[j] * rstd * fg[j], (f32x4*)(xr + 256 * j)); } }
}
}

#define XB_TMO      128
#define XB_XCNT(j)  (256  + 64 * (j))
#define XB_XSUB(j)  (1280 + 64 * (j))
#define XB_XGEN(j)  (2304 + 64 * (j))
#define XB_TOP      3328
#define XB_TOPGEN   3392
#define XCD_BAR_WORDS 3456
#define XB_SPIN_CAP (1u << 20)
__device__ __forceinline__ unsigned xb_ld(unsigned* p)              { return __hip_atomic_load(p, __ATOMIC_RELAXED, __HIP_MEMORY_SCOPE_AGENT); }
__device__ __forceinline__ unsigned xb_add(unsigned* p, unsigned v) { return __hip_atomic_fetch_add(p, v, __ATOMIC_RELAXED, __HIP_MEMORY_SCOPE_AGENT); }
__device__ __forceinline__ unsigned xb_xcc_id() { return (unsigned)__builtin_amdgcn_s_getreg((3 << 11) | 20) & 0xFu; }
#define XB_SPIN(cond, bar) do { unsigned _sp = 0; while (cond) { __builtin_amdgcn_s_sleep(1); \
    if ((++_sp & 255u) == 0u) { if (xb_ld(&(bar)[XB_TMO])) break; if (_sp > XB_SPIN_CAP) { atomicAdd(&(bar)[XB_TMO], 1u); break; } } } } while (0)
__device__ __forceinline__ void xcd_barrier_complete(unsigned* bar, unsigned x, unsigned& nloc, unsigned& nx) {
    const unsigned G = gridDim.x;
    unsigned sum, cnt, mine, sp = 0u;
    for (;;) {
        sum = 0u; cnt = 0u; mine = 0u;
#pragma unroll
        for (unsigned j = 0; j < 16; ++j) { const unsigned c = xb_ld(&bar[XB_XCNT(j)]); sum += c; cnt += (c > 0u) ? 1u : 0u; mine = (j == x) ? c : mine; }
        if (sum == G) break;
        __builtin_amdgcn_s_sleep(1);
        if ((++sp & 255u) == 0u) { if (xb_ld(&bar[XB_TMO])) break; if (sp > XB_SPIN_CAP) { atomicAdd(&bar[XB_TMO], 1u); break; } }
    }
    nloc = mine > 0u ? mine : 1u; nx = cnt > 0u ? cnt : 1u;
}
__device__ __forceinline__ void xcd_barrier(const int tid, unsigned* bar, volatile unsigned* st) {
    asm volatile("s_waitcnt vmcnt(0)" ::: "memory");
    __syncthreads();
    if (tid == 0) {
        __builtin_amdgcn_s_waitcnt(0);
        const unsigned x = xb_xcc_id();
        unsigned nloc = st[0], nx = st[1];
        if (nloc == 0u) { xcd_barrier_complete(bar, x, nloc, nx); st[0] = nloc; st[1] = nx; }
        const unsigned old = xb_add(&bar[XB_XSUB(x)], 1u);
        const unsigned gen = old / nloc;
        if (old + 1u == (gen + 1u) * nloc) {
            __builtin_amdgcn_fence(__ATOMIC_RELEASE, "agent");
            asm volatile("s_waitcnt vmcnt(0)" ::: "memory");
            const unsigned og = xb_add(&bar[XB_TOP], 1u);
            const unsigned tg = og / nx;
            if (og + 1u == (tg + 1u) * nx) xb_add(&bar[XB_TOPGEN], 1u);
            else XB_SPIN(xb_ld(&bar[XB_TOPGEN]) == tg, bar);
            __builtin_amdgcn_fence(__ATOMIC_ACQUIRE, "agent");
            xb_add(&bar[XB_XGEN(x)], 1u);
            asm volatile("s_waitcnt vmcnt(0)" ::: "memory");
        } else {
            XB_SPIN(xb_ld(&bar[XB_XGEN(x)]) == gen, bar);
            __builtin_amdgcn_fence(__ATOMIC_ACQUIRE, "agent");
            asm volatile("s_waitcnt vmcnt(0)" ::: "memory");
        }
    }
    __syncthreads();
}

#ifndef EN_MLA
#define EN_MLA 1
#endif
#ifndef EN_GLA
#define EN_GLA 1
#endif
#ifndef EN_PEER
#define EN_PEER 1
#endif
constexpr int NPHASE = 14;
#ifndef REPEAT_PHASE
#define REPEAT_PHASE -1
#endif
#define NREP(k) ((REPEAT_PHASE) == (k) ? 2 : 1)
#ifndef REPEAT_BAR
#define REPEAT_BAR 0
#endif
constexpr int MISC_OFF = LDS_BYTES - 64;

__global__ void __launch_bounds__(NTHREADS, 2) mega(Args ka) {
    extern __shared__ __attribute__((aligned(16))) unsigned char lds_raw[];
    char* lds = (char*)lds_raw; LAS unsigned char* lds3 = (LAS unsigned char*)lds_raw;
    const int lo = ka.ph_lo, hi = ka.ph_hi;
    const int wave_s = __builtin_amdgcn_readfirstlane((int)threadIdx.x >> 6);
#define FRESH_TID() ({ int l_; asm volatile("v_mbcnt_lo_u32_b32 %0, -1, 0\n\tv_mbcnt_hi_u32_b32 %0, -1, %0" : "=v"(l_)); (wave_s << 6) | l_; })
#define IN(k) (lo <= (k) && (k) < hi)
#define PHASE_VARS const int tid = FRESH_TID(); const Args a = fresh_args(); unsigned char* ws = a.ws; const int G = gridDim.x, bx = blockIdx.x; (void)G; (void)bx; (void)tid; \
    u64* ssq = (u64*)(ws + WS_CTL + CTL_SSQ); u64* sskv = (u64*)(ws + WS_CTL + CTL_SSKV); u64* ssx1 = (u64*)(ws + WS_CTL + CTL_SSX1); \
    const float* modz = (const float*)(ws + WS_CTL + CTL_MODZ); bf16_t* hbuf = (bf16_t*)(ws + WS_HBUF); bf16_t* proj = (bf16_t*)(ws + WS_PROJ); \
    (void)ssq; (void)sskv; (void)ssx1; (void)modz; (void)hbuf; (void)proj;
#ifndef PROBE_NBAR
#define PROBE_NBAR 1
#endif
#define SEAM(k) do { if (IN(k) && IN((k) + 1)) { for (int nb_ = 0; nb_ < PROBE_NBAR; ++nb_) { const int tid_ = FRESH_TID(); const Args a_ = fresh_args(); \
        xcd_barrier(tid_, (unsigned*)(a_.ws + WS_CTL + CTL_BAR), (volatile unsigned*)(lds + MISC_OFF)); } } } while (0)
    { const int tid = FRESH_TID(); if (tid < 2) ((volatile unsigned*)(lds + MISC_OFF))[tid] = 0u; __syncthreads();
      if (hi - lo > 1 && tid == 0) { const Args a_ = fresh_args(); (void)xb_add(&((unsigned*)(a_.ws + WS_CTL + CTL_BAR))[XB_XCNT(xb_xcc_id())], 1u); } }

    if (IN(0)) for (int rp = 0; rp < NREP(0); ++rp) { if (REPEAT_BAR && rp > 0) { const int tid_ = FRESH_TID(); const Args a_ = fresh_args(); xcd_barrier(tid_, (unsigned*)(a_.ws + WS_CTL + CTL_BAR), (volatile unsigned*)(lds + MISC_OFF)); } PHASE_VARS phase_p0(tid, a, lds, rp == 0); }
    SEAM(0);
    if (IN(1)) for (int rp = 0; rp < NREP(1); ++rp) { if (REPEAT_BAR && rp > 0) { const int tid_ = FRESH_TID(); const Args a_ = fresh_args(); xcd_barrier(tid_, (unsigned*)(a_.ws + WS_CTL + CTL_BAR), (volatile unsigned*)(lds + MISC_OFF)); } PHASE_VARS phase_rows<false>(tid, a); }
    SEAM(1);
    if (IN(2)) for (int rp = 0; rp < NREP(2); ++rp) { if (REPEAT_BAR && rp > 0) { const int tid_ = FRESH_TID(); const Args a_ = fresh_args(); xcd_barrier(tid_, (unsigned*)(a_.ws + WS_CTL + CTL_BAR), (volatile unsigned*)(lds + MISC_OFF)); } PHASE_VARS pg8::Gemm g{hbuf, (const bf16_t*)(ws + WS_BTIN), NTOK, NPROJ, DM / 2, DM / 2, DM / 2, 0}; pg8::StaticOrder S; S.init(NTOK, NPROJ, G, bx);
        pg8::EpiProj E{proj, NPROJ, ssq, sskv, rp == NREP(2) - 1, 1.f / (FP8_SA * FP8_SB)}; pg8::gemm_phase<true>(tid, lds3, g, S, E); }
    SEAM(2);
    if (IN(3)) for (int rp = 0; rp < NREP(3); ++rp) { if (REPEAT_BAR && rp > 0) { const int tid_ = FRESH_TID(); const Args a_ = fresh_args(); xcd_barrier(tid_, (unsigned*)(a_.ws + WS_CTL + CTL_BAR), (volatile unsigned*)(lds + MISC_OFF)); }
        { PHASE_VARS pg8::Gemm g{proj + PJ_CQ, (const bf16_t*)(ws + WS_BTUQ), NTOK, 1536, 512, NPROJ, 512, 0}; pg8::StaticOrder S; S.init(NTOK, 1536, G, bx);
          pg8::EpiQ E{ws + WS_QMLA, ssq, (const f32x2*)(ws + WS_CS)}; pg8::gemm_phase(tid, lds3, g, S, E); }
        { PHASE_VARS pg8::Gemm g{proj + PJ_CKV, (const bf16_t*)(ws + WS_BTK), NTOK, 1024, 256, NPROJ, 256, 0}; pg8::StaticOrder S; S.init(NTOK, 1024, G, bx);
          pg8::EpiK8 E{ws + WS_K8, sskv}; pg8::gemm_phase(tid, lds3, g, S, E); }
        { PHASE_VARS pg8::Gemm g{(const bf16_t*)(ws + WS_BTV), proj + PJ_CKV, 1024, NTOK, 256, 256, NPROJ, 0}; pg8::StaticOrder S; S.init(1024, NTOK, G, bx);
          pg8::EpiVT E{ws + WS_VT8, sskv}; pg8::gemm_phase(tid, lds3, g, S, E); }
        { PHASE_VARS phase_kpe(tid, a); }
        if (EN_GLA) { PHASE_VARS gla::phase_pre(tid, a, lds); }
    }
    SEAM(3);
    if (IN(4)) for (int rp = 0; rp < NREP(4); ++rp) { if (REPEAT_BAR && rp > 0) { const int tid_ = FRESH_TID(); const Args a_ = fresh_args(); xcd_barrier(tid_, (unsigned*)(a_.ws + WS_CTL + CTL_BAR), (volatile unsigned*)(lds + MISC_OFF)); }
        if (EN_GLA) { PHASE_VARS gla::phase_seq(tid, a, lds); }
        if (EN_MLA) { PHASE_VARS
            unsigned* qh = (unsigned*)(ws + WS_CTL + CTL_QUEUE) + 64 * ((bx & 7) + 8 * rp); volatile unsigned* qs = (volatile unsigned*)(lds + MISC_OFF + 16);
            for (;;) { { const int tq = FRESH_TID(); if (tq == 0) qs[0] = __hip_atomic_fetch_add(qh, 1u, __ATOMIC_RELAXED, __HIP_MEMORY_SCOPE_AGENT); }
                __syncthreads(); const unsigned j = qs[0]; __syncthreads();
                if (j >= 64u) break;
                const int bh = 4 * (bx & 7) + (int)(j & 3u), qb = 15 - (int)(j >> 2); att::attn_block(wave_s, a, lds, bh >> 3, bh & 7, qb); } }
        else { PHASE_VARS for (size_t i = (size_t)bx * NTHREADS + tid; i < (size_t)NTOK * 1024 / 8; i += (size_t)G * NTHREADS) { const size_t r = i >> 7, c8 = i & 127; *(u32x4*)(hbuf + r * DM + c8 * 8) = (u32x4){0u, 0u, 0u, 0u}; } }
    }
    SEAM(4);
    if (IN(5)) for (int rp = 0; rp < NREP(5); ++rp) { if (REPEAT_BAR && rp > 0) { const int tid_ = FRESH_TID(); const Args a_ = fresh_args(); xcd_barrier(tid_, (unsigned*)(a_.ws + WS_CTL + CTL_BAR), (volatile unsigned*)(lds + MISC_OFF)); }
        if (EN_GLA) { PHASE_VARS gla::phase_post(tid, a); }
        else { PHASE_VARS for (size_t i = (size_t)bx * NTHREADS + tid; i < (size_t)NTOK * 1024 / 8; i += (size_t)G * NTHREADS) { const size_t r = i >> 7, c8 = i & 127; *(u32x4*)(hbuf + r * DM + 1024 + c8 * 8) = (u32x4){0u, 0u, 0u, 0u}; } }
    }
    SEAM(5);
    if (IN(6)) for (int rp = 0; rp < NREP(6); ++rp) { if (REPEAT_BAR && rp > 0) { const int tid_ = FRESH_TID(); const Args a_ = fresh_args(); xcd_barrier(tid_, (unsigned*)(a_.ws + WS_CTL + CTL_BAR), (volatile unsigned*)(lds + MISC_OFF)); } PHASE_VARS pg8::Gemm g{hbuf, (const bf16_t*)(ws + WS_BTOUT), NTOK, DM, DM / 2, DM / 2, DM / 2, 0}; pg8::StaticOrder S; S.init(NTOK, DM, G, bx);
        pg8::EpiOut E{a.x, (bf16_t*)(ws + WS_X1), (bf16_t*)(ws + WS_Y), modz, a.ada_b, a.ffn_g, ssx1, rp == NREP(6) - 1, 1.f / (FP8_SA * FP8_SB)}; pg8::gemm_phase<true>(tid, lds3, g, S, E); }
    if (IN(7)) for (int rp = 0; rp < NREP(7); ++rp) { if (REPEAT_BAR && rp > 0) { const int tid_ = FRESH_TID(); const Args a_ = fresh_args(); xcd_barrier(tid_, (unsigned*)(a_.ws + WS_CTL + CTL_BAR), (volatile unsigned*)(lds + MISC_OFF)); } { PHASE_VARS phase_tables(tid, a, lds); } }
    SEAM(7);
    if (IN(8)) for (int rp = 0; rp < NREP(8); ++rp) { if (REPEAT_BAR && rp > 0) { const int tid_ = FRESH_TID(); const Args a_ = fresh_args(); xcd_barrier(tid_, (unsigned*)(a_.ws + WS_CTL + CTL_BAR), (volatile unsigned*)(lds + MISC_OFF)); }
        PHASE_VARS pg8::Gemm g{(const bf16_t*)(ws + WS_Y), (const bf16_t*)(ws + WS_BTQ), NTOK, DM, DM, DM, DM, 0}; pg8::StaticOrder S; S.init(NTOK, DM, G, bx);
        pg8::EpiTopK E{(int*)(ws + WS_EXPERTS), (float*)(ws + WS_GATES), ssx1, (const float*)(ws + WS_CSH), (unsigned short*)(ws + WS_EXP16)};
        for (int i = 0; ; ++i) { pg8::Unit un; if (!S.next(i, un)) break; pg8::SingleUnit S1{un}; pg8::gemm_phase(tid, lds3, g, S1, E); } }
    SEAM(8);
    if (IN(9) && !IN(8) && IN(10)) {}
    if (IN(10)) for (int rp = 0; rp < NREP(10); ++rp) { if (REPEAT_BAR && rp > 0) { const int tid_ = FRESH_TID(); const Args a_ = fresh_args(); xcd_barrier(tid_, (unsigned*)(a_.ws + WS_CTL + CTL_BAR), (volatile unsigned*)(lds + MISC_OFF)); } PHASE_VARS peer::phase_u(tid, a); }
    SEAM(10);
    if (IN(11)) for (int rp = 0; rp < NREP(11); ++rp) { if (REPEAT_BAR && rp > 0) { const int tid_ = FRESH_TID(); const Args a_ = fresh_args(); xcd_barrier(tid_, (unsigned*)(a_.ws + WS_CTL + CTL_BAR), (volatile unsigned*)(lds + MISC_OFF)); } PHASE_VARS peer::phase_w(tid, a); }
    SEAM(11);
    if (IN(12)) for (int rp = 0; rp < NREP(12); ++rp) { if (REPEAT_BAR && rp > 0) { const int tid_ = FRESH_TID(); const Args a_ = fresh_args(); xcd_barrier(tid_, (unsigned*)(a_.ws + WS_CTL + CTL_BAR), (volatile unsigned*)(lds + MISC_OFF)); } PHASE_VARS peer::phase_v(tid, a); }
    SEAM(12);
    if (IN(13)) { PHASE_VARS peer::phase_final(tid, a); }
#undef IN
#undef SEAM
#undef PHASE_VARS
#undef FRESH_TID
}

#ifndef N_LAUNCH_MODE
#define N_LAUNCH_MODE 1
#endif
extern "C" void kernel_launch(void* const* d_in, const int* in_sizes, int n_in, void* d_out, int out_size, void* d_ws, size_t ws_size, hipStream_t stream) {
    static int grid = 0;
    if (grid == 0) {
        if (n_in != 22 || out_size != NTOK * DM || ws_size < WS_NEED) { fprintf(stderr, "kernel_launch: unexpected problem (n_in %d, out %d, ws %zu)\n", n_in, out_size, ws_size); grid = -1; return; }
        int dev = 0, cus = 0, per_cu = 0;
        (void)hipGetDevice(&dev); (void)hipDeviceGetAttribute(&cus, hipDeviceAttributeMultiprocessorCount, dev);
        if (hipFuncSetAttribute((const void*)mega, hipFuncAttributeMaxDynamicSharedMemorySize, LDS_BYTES) != hipSuccess) { fprintf(stderr, "kernel_launch: hipFuncSetAttribute failed\n"); grid = -1; return; }
        if (hipOccupancyMaxActiveBlocksPerMultiprocessor(&per_cu, (const void*)mega, NTHREADS, LDS_BYTES) != hipSuccess || per_cu < 1) { fprintf(stderr, "kernel_launch: occupancy query says %d\n", per_cu); per_cu = 1; }
        (void)hipGetLastError();
        grid = cus * 1;
        if (per_cu < 1) grid = -1;
        fprintf(stderr, "kernel_launch: cus %d per_cu %d grid %d\n", cus, per_cu, grid);
    }
    if (grid < 0) return;
    (void)hipMemsetAsync((char*)d_ws + WS_CTL, 0, CTL_BYTES, stream);
    Args a{};
    a.x = (const float*)d_in[0]; a.c = (const float*)d_in[1]; a.pos = (const int*)d_in[2]; a.ada_w = (const float*)d_in[3]; a.ada_b = (const float*)d_in[4]; a.mix_g = (const float*)d_in[5];
    a.w_in = (const float*)d_in[6]; a.qn_g = (const float*)d_in[7]; a.w_uq = (const float*)d_in[8]; a.kvn_g = (const float*)d_in[9]; a.w_ukv = (const float*)d_in[10]; a.mla_og = (const float*)d_in[11];
    a.w_gate2 = (const float*)d_in[12]; a.b_gate = (const float*)d_in[13]; a.gla_og = (const float*)d_in[14]; a.w_out = (const float*)d_in[15]; a.ffn_g = (const float*)d_in[16];
    a.w_q = (const float*)d_in[17]; a.sub_keys = (const float*)d_in[18]; a.u_tab = (const float*)d_in[19]; a.v_tab = (const float*)d_in[20]; a.fin_g = (const float*)d_in[21];
    a.out = (float*)d_out; a.ws = (unsigned char*)d_ws;
#if N_LAUNCH_MODE == 1
    a.ph_lo = 0; a.ph_hi = NPHASE;
    void* args[] = {&a};
    hipError_t e = hipLaunchCooperativeKernel((const void*)mega, dim3(grid), dim3(NTHREADS), args, LDS_BYTES, stream);
    if (e != hipSuccess) fprintf(stderr, "kernel_launch: cooperative launch failed: %s (grid %d)\n", hipGetErrorString(e), grid);
#else
    for (int p = 0; p < NPHASE; ++p) { a.ph_lo = p; a.ph_hi = p + 1; hipLaunchKernelGGL(mega, dim3(grid), dim3(NTHREADS), LDS_BYTES, stream, a); }
#endif
}
```

```cpp
#include <hip/hip_runtime.h>
#include <hip/hip_cooperative_groups.h>
#include <cstdio>
#include <cstdint>
namespace cg = cooperative_groups;

constexpr int NB = 4, SEQ = 4096, DM = 2048, NTOK = NB * SEQ;
constexpr float EPS = 1e-6f;
constexpr int NPROJ = 4096;
constexpr int PJ_CQ = 0, PJ_CKV = 512, PJ_GQ = 768, PJ_GK = 1280, PJ_GV = 1792, PJ_GR = 2816, PJ_KPE = 3840, PJ_GLR = 3904, PJ_END = 3920;
constexpr int MOD_SH1 = 0, MOD_SC1 = 2048, MOD_G1 = 4096, MOD_SH2 = 6144, MOD_SC2 = 8192, MOD_G2 = 10240, NMOD = 12288;
constexpr float QSCALE = 0.07216878364870322f * 1.4426950408889634f;
constexpr float GLA_QS = 0.08838834764831845f;

constexpr size_t MiB = 1u << 20;
constexpr size_t WS_CTL = 0, CTL_BYTES = 2 * MiB;
constexpr size_t CTL_BAR = 0, CTL_MODZI = 16384, CTL_SSQ = 409600, CTL_SSKV = 540672, CTL_SSX1 = 671744, CTL_MODZ = 802816, CTL_SSF = 1048576, CTL_QUEUE = 1048576 + 131072;
constexpr size_t WS_BTIN = 2 * MiB, WS_BTUQ = 18 * MiB, WS_BTUKV = 20 * MiB, WS_BTKEYS = 21 * MiB, WS_BTOUT = 22 * MiB, WS_BTQ = 30 * MiB;
constexpr size_t WS_CS = 38 * MiB, WS_KPE = 42 * MiB, WS_GATES = 44 * MiB, WS_EXPERTS = 52 * MiB, WS_DECAY = 60 * MiB;
constexpr size_t WS_UTAB = 64 * MiB, WS_VTAB = 96 * MiB, WS_USC = 61 * MiB, WS_VSC = 61 * MiB + 65536;
constexpr size_t WS_GLAU = 64 * MiB;
constexpr size_t WS_SC4 = 62 * MiB;
constexpr size_t WS_USH = 61 * MiB + 131072;
constexpr size_t WS_CSH = 61 * MiB + 524288;
constexpr size_t WS_Y = 128 * MiB;
constexpr size_t WS_EXP16 = 392 * MiB;
constexpr size_t WS_X1 = 432 * MiB;
constexpr size_t WS_HBUF = 192 * MiB;
constexpr size_t WS_PROJ = 256 * MiB;
constexpr size_t WS_BTK = 20 * MiB, WS_BTV = 20 * MiB + 524288;
constexpr size_t WS_K8 = 432 * MiB, WS_VT8 = 448 * MiB;
constexpr size_t WS_QMLA = 384 * MiB, WS_KV = 432 * MiB;
constexpr size_t WS_SCORES = 384 * MiB;
constexpr size_t WS_WTS = 384 * MiB;
constexpr size_t WS_PART = 256 * MiB;
constexpr size_t WS_NEED = 512 * MiB;

#define LAS __attribute__((address_space(3)))
typedef unsigned short bf16_t;
typedef short bf16x8 __attribute__((ext_vector_type(8)));
typedef int i32x4v __attribute__((ext_vector_type(4)));
typedef int i32x8v __attribute__((ext_vector_type(8)));
typedef short s16x4 __attribute__((ext_vector_type(4)));
typedef float f32x4 __attribute__((ext_vector_type(4)));
typedef float f32x2 __attribute__((ext_vector_type(2)));
typedef float f32x16 __attribute__((ext_vector_type(16)));
typedef unsigned u32x4 __attribute__((ext_vector_type(4)));
typedef unsigned u32x2 __attribute__((ext_vector_type(2)));
typedef __bf16 bf16x2_t __attribute__((ext_vector_type(2)));

__device__ __forceinline__ unsigned cvt_pk_bf16(float lo, float hi) { f32x2 v = {lo, hi}; bf16x2_t b = __builtin_convertvector(v, bf16x2_t); return __builtin_bit_cast(unsigned, b); }
__device__ __forceinline__ float bf_lo(unsigned w) { return __uint_as_float(w << 16); }
__device__ __forceinline__ float bf_hi(unsigned w) { return __uint_as_float(w & 0xffff0000u); }
__device__ __forceinline__ float bf2f(bf16_t h) { return __uint_as_float(((unsigned)h) << 16); }
__device__ __forceinline__ bf16_t f2bf(float f) { return (bf16_t)(cvt_pk_bf16(f, 0.f) & 0xffffu); }
__device__ __forceinline__ float dot2_bf16(unsigned a, unsigned b, float acc) { return __builtin_amdgcn_fdot2_f32_bf16(__builtin_bit_cast(bf16x2_t, a), __builtin_bit_cast(bf16x2_t, b), acc, false); }
template <int CTRL> __device__ __forceinline__ float dppf(float x) { return __builtin_bit_cast(float, __builtin_amdgcn_update_dpp(0, __builtin_bit_cast(int, x), CTRL, 0xF, 0xF, false)); }
__device__ __forceinline__ float lx1(float x) { return dppf<0xB1>(x); }
__device__ __forceinline__ float lx2(float x) { return dppf<0x4E>(x); }
__device__ __forceinline__ float lx7(float x) { return dppf<0x141>(x); }
__device__ __forceinline__ float lx8(float x) { return dppf<0x128>(x); }
__device__ __forceinline__ float lx16(float x, int lane) { auto r = __builtin_amdgcn_permlane16_swap(__float_as_uint(x), __float_as_uint(x), false, false); return __uint_as_float((lane & 16) ? r[0] : r[1]); }
__device__ __forceinline__ float lx32(float x, int lane) { auto r = __builtin_amdgcn_permlane32_swap(__float_as_uint(x), __float_as_uint(x), false, false); return __uint_as_float((lane & 32) ? r[0] : r[1]); }
__device__ __forceinline__ float wave_sum(float v) {
    v += lx1(v); v += lx2(v); v += lx7(v); v += lx8(v);
    { auto r = __builtin_amdgcn_permlane16_swap(__float_as_uint(v), __float_as_uint(v), false, false); v = __uint_as_float(r[0]) + __uint_as_float(r[1]); }
    { auto r = __builtin_amdgcn_permlane32_swap(__float_as_uint(v), __float_as_uint(v), false, false); v = __uint_as_float(r[0]) + __uint_as_float(r[1]); }
    return v;
}

typedef unsigned long long u64;
__device__ __forceinline__ void ss_add(u64* p, float v) { atomicAdd(p, (u64)((double)v * 4294967296.0)); }
__device__ __forceinline__ float ss_get(const u64* p) { const u64 v = *p; return ((float)(unsigned)(v >> 32) * 4294967296.f + (float)(unsigned)v) * (1.f / 4294967296.f); }
__device__ __forceinline__ void mz_add(u64* p, float v) { atomicAdd(p, (u64)(long long)((double)v * 1099511627776.0)); }
__device__ __forceinline__ float mz_get(const u64* p) { const u64 v = *p; return ((float)(int)(unsigned)(v >> 32) * 4294967296.f + (float)(unsigned)v) * (1.f / 1099511627776.f); }

constexpr float FP8_SA = 32.f, FP8_SB = 2048.f;
__device__ __forceinline__ unsigned pk4_fp8(float a, float b, float c, float d, float S) {
    a = __builtin_amdgcn_fmed3f(a * S, -448.f, 448.f); b = __builtin_amdgcn_fmed3f(b * S, -448.f, 448.f); c = __builtin_amdgcn_fmed3f(c * S, -448.f, 448.f); d = __builtin_amdgcn_fmed3f(d * S, -448.f, 448.f);
    int p = __builtin_amdgcn_cvt_pk_fp8_f32(a, b, 0, false); p = __builtin_amdgcn_cvt_pk_fp8_f32(c, d, p, true); return (unsigned)p; }
constexpr float FP8_SQ = 256.f, FP8_SK = 32.f;
namespace pg8 {
constexpr int BM = 256, BK = 64, HALF = 128, HTB = HALF * BK * 2, STAGE_BYTES = 8 * HTB, NXCD = 8, WGM = 8;
__host__ __device__ __forceinline__ int lds_byte(int r, int c) { const int st = (r >> 4) * 2 + (c >> 5), rr = r & 15, cc = c & 31, ob = rr * 64 + cc * 2; return st * 1024 + (ob ^ (((ob >> 9) & 1) << 5)); }
__host__ __device__ __forceinline__ void stage_rc(int b, int& R, int& C) { const int st = b / 1024, sb = b % 1024, swz = sb ^ (((sb >> 9) & 1) << 5); R = (st >> 1) * 16 + swz / 64; C = (st & 1) * 32 + (swz % 64) / 2; }
__host__ __device__ __forceinline__ int perm32(int rho) { const int n = rho >> 4, i = rho & 15; return 8 * (i >> 2) + 4 * n + (i & 3); }

struct Unit { int pm, pn; };
struct Gemm { const bf16_t* A; const bf16_t* Bt; int M, N, K, lda, ldb, a_pn_stride; };

struct StaticOrder {
    int nM, nN, nwg, G, c;
    __host__ __device__ void init(int M, int N, int G_, int c_) { nM = M / BM; nN = N / BM; nwg = nM * nN; G = G_; c = c_; }
    __host__ __device__ bool next(int i, Unit& u) const {
        const long L = (long)i * G + c; if (L >= nwg) return false;
        int wgid = (int)L; { const int q = nwg / NXCD, r = nwg % NXCD, xcd = wgid % NXCD, off = wgid / NXCD; wgid = (xcd < r ? xcd * (q + 1) : r * (q + 1) + (xcd - r) * q) + off; }
        const int nig = WGM * nN, gid = wgid / nig, fm = gid * WGM, gsz = (nM - fm) < WGM ? (nM - fm) : WGM;
        u.pm = fm + ((wgid % nig) % gsz); u.pn = (wgid % nig) / gsz; return true;
    }
};

struct SingleUnit { Unit u0; __device__ __forceinline__ bool next(int i, Unit& u) const { if (i) return false; u = u0; return true; } };
template <bool FP8 = false, class Epi, class Sched>
__device__ __forceinline__ void gemm_phase(const int tid, LAS unsigned char* lds, const Gemm g, const Sched& S, const Epi& E) {
    const int wid = __builtin_amdgcn_readfirstlane(tid >> 6), lane = tid & 63, wr = wid >> 2, wc = wid & 3, fr = lane & 15, fq = lane >> 4;
    const int K = g.K, nt = K / BK;
    unsigned voffA[2], voffB[2];
#pragma unroll
    for (int i = 0; i < 2; ++i) { int R, C; stage_rc(tid * 16 + i * 8192, R, C); const int Rb = (R & ~31) + perm32(R & 31);
        voffA[i] = (unsigned)(R * g.lda + C) * 2u; voffB[i] = (unsigned)(Rb * g.ldb + C) * 2u; }
    const size_t kstep = (size_t)(BK * 2);
    const size_t hsA = (size_t)HALF * g.lda * 2, hsB = (size_t)HALF * g.ldb * 2;
    const size_t tsA = 2 * hsA, tsB = 2 * hsB;
    const unsigned ldsw = (unsigned)wid * 1024u;
    const int aoff = lds_byte(wr * 64 + fr, fq * 8), boff = lds_byte(wc * 32 + fr, fq * 8);
#define PG8_SA(b, h) (((b) * 2 + (h)) * HTB)
#define PG8_SB(b, h) ((4 + (b) * 2 + (h)) * HTB)
#define PG8_STAGE(bufoff, gbase, voff) do { _Pragma("unroll") for (int _i = 0; _i < 2; ++_i) \
        __builtin_amdgcn_global_load_lds((const unsigned*)((const char*)(gbase) + (voff)[_i]), (LAS unsigned*)(lds + (bufoff) + ldsw + _i * 8192), 16, 0, 0); } while (0)
#define PG8_LDA(dst, b, h) do { if constexpr (FP8) { _Pragma("unroll") for (int m = 0; m < 4; ++m) { const i32x4v lo_ = *(const LAS i32x4v*)(lds + PG8_SA(b, h) + aoff + m * 2048), hi_ = *(const LAS i32x4v*)(lds + PG8_SA(b, h) + aoff + m * 2048 + 1024); \
            dst##8[m] = __builtin_shufflevector(lo_, hi_, 0, 1, 2, 3, 4, 5, 6, 7); } }     \
        else { _Pragma("unroll") for (int m = 0; m < 4; ++m) _Pragma("unroll") for (int k = 0; k < 2; ++k) dst[m][k] = *(const LAS bf16x8*)(lds + PG8_SA(b, h) + aoff + m * 2048 + k * 1024); } } while (0)
#define PG8_LDB(dst, b, h) do { if constexpr (FP8) { _Pragma("unroll") for (int n = 0; n < 2; ++n) { const i32x4v lo_ = *(const LAS i32x4v*)(lds + PG8_SB(b, h) + boff + n * 2048), hi_ = *(const LAS i32x4v*)(lds + PG8_SB(b, h) + boff + n * 2048 + 1024); \
            dst##8[n] = __builtin_shufflevector(lo_, hi_, 0, 1, 2, 3, 4, 5, 6, 7); } } \
        else { _Pragma("unroll") for (int n = 0; n < 2; ++n) _Pragma("unroll") for (int k = 0; k < 2; ++k) dst[n][k] = *(const LAS bf16x8*)(lds + PG8_SB(b, h) + boff + n * 2048 + k * 1024); } } while (0)
#define PG8_MMA(ai, bj, At, Bt) do { __builtin_amdgcn_s_setprio(1); _Pragma("unroll") for (int m = 0; m < 4; ++m) _Pragma("unroll") for (int n = 0; n < 2; ++n) { \
        if constexpr (FP8) asm volatile("v_mfma_f32_16x16x128_f8f6f4 %0, %1, %2, %0" : "+v"(acc[ai][bj][m][n]) : "v"(Bt##8[n]), "v"(At##8[m]));     \
        else { _Pragma("unroll") for (int k = 0; k < 2; ++k) acc[ai][bj][m][n] = __builtin_amdgcn_mfma_f32_16x16x32_bf16(Bt[n][k], At[m][k], acc[ai][bj][m][n], 0, 0, 0); } } __builtin_amdgcn_s_setprio(0); } while (0)
#define PG8_WAIT_V(n) asm volatile("s_waitcnt vmcnt(" #n ")" ::: "memory")
#define PG8_WAIT_L(n) asm volatile("s_waitcnt lgkmcnt(" #n ")" ::: "memory")
#define PG8_BAR __builtin_amdgcn_s_barrier()
#define PG8_SCHED __builtin_amdgcn_sched_barrier(0)
    Unit cur, nxt; int ui = 0;
    if (!S.next(0, cur)) return;
    f32x4 acc[2][2][4][2];
#pragma unroll
    for (int a = 0; a < 2; ++a)
#pragma unroll
        for (int b = 0; b < 2; ++b)
#pragma unroll
            for (int m = 0; m < 4; ++m)
#pragma unroll
                for (int n = 0; n < 2; ++n) acc[a][b][m][n] = (f32x4){0.f, 0.f, 0.f, 0.f};
    bf16x8 At[4][2], B0[2][2], B1[2][2]; i32x8v At8[4], B08[2], B18[2];
    const char* cA = (const char*)g.A + (size_t)cur.pm * tsA + (size_t)cur.pn * g.a_pn_stride * 2; const char* cB = (const char*)g.Bt + (size_t)cur.pn * tsB;
    PG8_STAGE(PG8_SB(0, 0), cB, voffB); PG8_STAGE(PG8_SB(0, 1), cB + hsB, voffB); PG8_STAGE(PG8_SA(0, 0), cA, voffA); PG8_STAGE(PG8_SA(0, 1), cA + hsA, voffA);
    if (wr == 1) PG8_BAR;
    PG8_WAIT_V(2); PG8_BAR;
    PG8_STAGE(PG8_SB(1, 0), cB + kstep, voffB); PG8_STAGE(PG8_SA(1, 0), cA + kstep, voffA); PG8_STAGE(PG8_SB(1, 1), cB + hsB + kstep, voffB);
    PG8_WAIT_V(6); PG8_BAR;
    for (;;) {
        const bool has_next = S.next(ui + 1, nxt);
        const char* nA = has_next ? (const char*)g.A + (size_t)nxt.pm * tsA + (size_t)nxt.pn * g.a_pn_stride * 2 : cA; const char* nB = has_next ? (const char*)g.Bt + (size_t)nxt.pn * tsB : cB;
        for (int t = 0; t < nt; t += 2) {
            const bool last = (t == nt - 2);
            const char* a1 = cA + (size_t)(t + 1) * kstep;
            const char* a2 = last ? nA : cA + (size_t)(t + 2) * kstep; const char* b2 = last ? nB : cB + (size_t)(t + 2) * kstep;
            const char* a3 = a2 + kstep; const char* b3 = b2 + kstep;
            PG8_LDB(B0, 0, 0); PG8_LDB(B1, 0, 1); PG8_SCHED; PG8_LDA(At, 0, 0); PG8_STAGE(PG8_SA(1, 1), a1 + hsA, voffA);
            PG8_WAIT_V(8); PG8_WAIT_L(0); PG8_BAR; PG8_MMA(0, 0, At, B0); PG8_MMA(0, 1, At, B1); PG8_BAR; PG8_SCHED;
            PG8_LDA(At, 0, 1); PG8_STAGE(PG8_SB(0, 0), b2, voffB); PG8_STAGE(PG8_SB(0, 1), b2 + hsB, voffB); PG8_STAGE(PG8_SA(0, 0), a2, voffA);
            PG8_WAIT_V(8); PG8_WAIT_L(0); PG8_BAR; PG8_MMA(1, 0, At, B0); PG8_MMA(1, 1, At, B1); PG8_BAR; PG8_SCHED;
            PG8_LDB(B0, 1, 0); PG8_LDB(B1, 1, 1); PG8_SCHED; PG8_LDA(At, 1, 0); PG8_STAGE(PG8_SA(0, 1), a2 + hsA, voffA);
            PG8_WAIT_V(8); PG8_WAIT_L(0); PG8_BAR; PG8_MMA(0, 0, At, B0); PG8_MMA(0, 1, At, B1); PG8_BAR; PG8_SCHED;
            PG8_LDA(At, 1, 1); PG8_STAGE(PG8_SB(1, 0), b3, voffB); PG8_STAGE(PG8_SB(1, 1), b3 + hsB, voffB); PG8_STAGE(PG8_SA(1, 0), a3, voffA);
            PG8_WAIT_V(8); PG8_WAIT_L(0); PG8_BAR; PG8_MMA(1, 0, At, B0); PG8_MMA(1, 1, At, B1); PG8_BAR; PG8_SCHED;
        }
        if constexpr (FP8) asm volatile("s_nop 15\n\ts_nop 15" ::: "memory");
        if (wr == 0) PG8_BAR;
        if constexpr (!Epi::AFTER_DRAIN) E(acc, cur, wr, wc, fr, fq);
        if (!has_next) break;
#pragma unroll
        for (int a = 0; a < 2; ++a)
#pragma unroll
            for (int b = 0; b < 2; ++b)
#pragma unroll
                for (int m = 0; m < 4; ++m)
#pragma unroll
                    for (int n = 0; n < 2; ++n) acc[a][b][m][n] = (f32x4){0.f, 0.f, 0.f, 0.f};
        cur = nxt; cA = nA; cB = nB; ++ui;
        if (wr == 1) PG8_BAR;
    }
    PG8_WAIT_V(0);
    PG8_BAR;
    if constexpr (Epi::AFTER_DRAIN) E.fused(acc, cur, wr, wc, fr, fq, lds, tid);
#undef PG8_SA
#undef PG8_SB
#undef PG8_STAGE
#undef PG8_LDA
#undef PG8_LDB
#undef PG8_MMA
#undef PG8_WAIT_V
#undef PG8_WAIT_L
#undef PG8_BAR
#undef PG8_SCHED
}

#define EPI_LOOP_HEAD const int row0 = u.pm * BM + wr * 64 + fr; const int col0 = u.pn * BM + wc * 32 + 8 * fq;

struct EpiProj {
    static constexpr bool AFTER_DRAIN = false;
    bf16_t* O; int ldc; u64* ssq; u64* sskv; bool do_ss; float osc;
    __device__ __forceinline__ void operator()(const f32x4 (&acc)[2][2][4][2], const Unit& u, int wr, int wc, int fr, int fq) const {
        EPI_LOOP_HEAD
        u64* ssp = !do_ss ? nullptr : ((u.pn < 2) ? ssq : ((u.pn == 2) ? sskv : nullptr));
#pragma unroll
        for (int ai = 0; ai < 2; ++ai)
#pragma unroll
            for (int m = 0; m < 4; ++m) { const int row = row0 + ai * HALF + m * 16; bf16_t* rowp = O + (size_t)row * ldc + col0; float ss = 0.f;
#pragma unroll
                for (int bj = 0; bj < 2; ++bj) { const f32x4 v0 = acc[ai][bj][m][0] * osc, v1 = acc[ai][bj][m][1] * osc;
                    u32x4 w; w.x = cvt_pk_bf16(v0[0], v0[1]); w.y = cvt_pk_bf16(v0[2], v0[3]); w.z = cvt_pk_bf16(v1[0], v1[1]); w.w = cvt_pk_bf16(v1[2], v1[3]);
                    *(u32x4*)(rowp + bj * HALF) = w;
                    ss += bf_lo(w.x) * bf_lo(w.x) + bf_hi(w.x) * bf_hi(w.x) + bf_lo(w.y) * bf_lo(w.y) + bf_hi(w.y) * bf_hi(w.y)
                        + bf_lo(w.z) * bf_lo(w.z) + bf_hi(w.z) * bf_hi(w.z) + bf_lo(w.w) * bf_lo(w.w) + bf_hi(w.w) * bf_hi(w.w); }
                if (ssp) { ss += __shfl_xor(ss, 16); ss += __shfl_xor(ss, 32); if (fq == 0) ss_add(ssp + row, ss); } }
    }
};
struct EpiQ {
    static constexpr bool AFTER_DRAIN = false;
    unsigned char* O; const u64* ssq; const f32x2* cs;
    __device__ __forceinline__ void operator()(const f32x4 (&acc)[2][2][4][2], const Unit& u, int wr, int wc, int fr, int fq) const {
        EPI_LOOP_HEAD
#pragma unroll
        for (int ai = 0; ai < 2; ++ai)
#pragma unroll
            for (int m = 0; m < 4; ++m) { const int row = row0 + ai * HALF + m * 16; const float rs = rsqrtf(ss_get(ssq + row) * (1.f / 512.f) + EPS) * QSCALE;
#pragma unroll
                for (int bj = 0; bj < 2; ++bj) { const int col = col0 + bj * HALF; const int hd = col / 192, j = col - hd * 192;
                    f32x4 v0 = acc[ai][bj][m][0] * rs, v1 = acc[ai][bj][m][1] * rs;
                    if (j >= 128) { const int i0 = (j - 128) >> 1; const f32x4 c01 = *(const f32x4*)(cs + (size_t)row * 32 + i0), c23 = *(const f32x4*)(cs + (size_t)row * 32 + i0 + 2);
                        f32x4 r0, r1;
                        r0[0] = v0[0] * c01[0] - v0[1] * c01[1]; r0[1] = v0[1] * c01[0] + v0[0] * c01[1];
                        r0[2] = v0[2] * c01[2] - v0[3] * c01[3]; r0[3] = v0[3] * c01[2] + v0[2] * c01[3];
                        r1[0] = v1[0] * c23[0] - v1[1] * c23[1]; r1[1] = v1[1] * c23[0] + v1[0] * c23[1];
                        r1[2] = v1[2] * c23[2] - v1[3] * c23[3]; r1[3] = v1[3] * c23[2] + v1[2] * c23[3];
                        v0 = r0; v1 = r1; }
                    *(u32x2*)(O + (size_t)row * 1536 + col) = (u32x2){pk4_fp8(v0[0], v0[1], v0[2], v0[3], FP8_SQ), pk4_fp8(v1[0], v1[1], v1[2], v1[3], FP8_SQ)}; } }
    }
};
struct EpiK8 {
    static constexpr bool AFTER_DRAIN = false;
    unsigned char* O; const u64* sskv;
    __device__ __forceinline__ void operator()(const f32x4 (&acc)[2][2][4][2], const Unit& u, int wr, int wc, int fr, int fq) const {
        EPI_LOOP_HEAD
#pragma unroll
        for (int ai = 0; ai < 2; ++ai)
#pragma unroll
            for (int m = 0; m < 4; ++m) { const int row = row0 + ai * HALF + m * 16; const float rs = rsqrtf(ss_get(sskv + row) * (1.f / 256.f) + EPS);
#pragma unroll
                for (int bj = 0; bj < 2; ++bj) { const f32x4 v0 = acc[ai][bj][m][0] * rs, v1 = acc[ai][bj][m][1] * rs;
                    *(u32x2*)(O + (size_t)row * 1024 + col0 + bj * HALF) = (u32x2){pk4_fp8(v0[0], v0[1], v0[2], v0[3], FP8_SK), pk4_fp8(v1[0], v1[1], v1[2], v1[3], FP8_SK)}; } }
    }
};
struct EpiVT {
    static constexpr bool AFTER_DRAIN = false;
    unsigned char* O; const u64* sskv;
    __device__ __forceinline__ void operator()(const f32x4 (&acc)[2][2][4][2], const Unit& u, int wr, int wc, int fr, int fq) const {
        EPI_LOOP_HEAD
        f32x4 rs[2][2];
#pragma unroll
        for (int bj = 0; bj < 2; ++bj)
#pragma unroll
            for (int n = 0; n < 2; ++n)
#pragma unroll
                for (int q = 0; q < 4; ++q) rs[bj][n][q] = rsqrtf(ss_get(sskv + col0 + bj * HALF + 4 * n + q) * (1.f / 256.f) + EPS);
#pragma unroll
        for (int ai = 0; ai < 2; ++ai)
#pragma unroll
            for (int m = 0; m < 4; ++m) { const int row = row0 + ai * HALF + m * 16;
#pragma unroll
                for (int bj = 0; bj < 2; ++bj) { const f32x4 v0 = acc[ai][bj][m][0] * rs[bj][0], v1 = acc[ai][bj][m][1] * rs[bj][1];
                    *(u32x2*)(O + (size_t)row * NTOK + col0 + bj * HALF) = (u32x2){pk4_fp8(v0[0], v0[1], v0[2], v0[3], FP8_SK), pk4_fp8(v1[0], v1[1], v1[2], v1[3], FP8_SK)}; } }
    }
};
struct EpiOut {
    static constexpr bool AFTER_DRAIN = false;
    const float* x; bf16_t* x1b; bf16_t* yb; const float* modz; const float* ada_b; const float* ffn_g; u64* ssx1; bool do_ss; float osc;
    __device__ __forceinline__ void operator()(const f32x4 (&acc)[2][2][4][2], const Unit& u, int wr, int wc, int fr, int fq) const {
        EPI_LOOP_HEAD
        const int b = u.pm >> 4;
        f32x4 g[2][2], gm[2][2];
#pragma unroll
        for (int bj = 0; bj < 2; ++bj)
#pragma unroll
            for (int n = 0; n < 2; ++n) { const int col = col0 + bj * HALF + 4 * n;
                g[bj][n] = (*(const f32x4*)(modz + (size_t)b * NMOD + MOD_G1 + col) + *(const f32x4*)(ada_b + MOD_G1 + col)) * osc;
                gm[bj][n] = *(const f32x4*)(ffn_g + col) * (*(const f32x4*)(modz + (size_t)b * NMOD + MOD_SC2 + col) + *(const f32x4*)(ada_b + MOD_SC2 + col) + 1.f); }
#pragma unroll
        for (int ai = 0; ai < 2; ++ai)
#pragma unroll
            for (int m = 0; m < 4; ++m) { const int row = row0 + ai * HALF + m * 16; const size_t off = (size_t)row * DM + col0; float ss = 0.f;
#pragma unroll
                for (int bj = 0; bj < 2; ++bj) { f32x4 o[2];
#pragma unroll
                    for (int n = 0; n < 2; ++n) { const f32x4 xv = *(const f32x4*)(x + off + bj * HALF + 4 * n); o[n] = xv + g[bj][n] * acc[ai][bj][m][n];
                        ss += o[n][0] * o[n][0] + o[n][1] * o[n][1] + o[n][2] * o[n][2] + o[n][3] * o[n][3]; }
                    *(u32x4*)(x1b + off + bj * HALF) = (u32x4){cvt_pk_bf16(o[0][0], o[0][1]), cvt_pk_bf16(o[0][2], o[0][3]), cvt_pk_bf16(o[1][0], o[1][1]), cvt_pk_bf16(o[1][2], o[1][3])};
                    const f32x4 y0 = o[0] * gm[bj][0], y1 = o[1] * gm[bj][1];
                    *(u32x4*)(yb + off + bj * HALF) = (u32x4){cvt_pk_bf16(y0[0], y0[1]), cvt_pk_bf16(y0[2], y0[3]), cvt_pk_bf16(y1[0], y1[1]), cvt_pk_bf16(y1[2], y1[3])}; }
                ss += __shfl_xor(ss, 16); ss += __shfl_xor(ss, 32); if (fq == 0 && do_ss) ss_add(ssx1 + row, ss); }
    }
};
struct EpiBf16 {
    static constexpr bool AFTER_DRAIN = false;
    bf16_t* O; int ldc;
    __device__ __forceinline__ void operator()(const f32x4 (&acc)[2][2][4][2], const Unit& u, int wr, int wc, int fr, int fq) const {
        EPI_LOOP_HEAD
#pragma unroll
        for (int ai = 0; ai < 2; ++ai)
#pragma unroll
            for (int m = 0; m < 4; ++m) { const int row = row0 + ai * HALF + m * 16; bf16_t* rowp = O + (size_t)row * ldc + col0;
#pragma unroll
                for (int bj = 0; bj < 2; ++bj) { const f32x4 v0 = acc[ai][bj][m][0], v1 = acc[ai][bj][m][1];
                    u32x4 w; w.x = cvt_pk_bf16(v0[0], v0[1]); w.y = cvt_pk_bf16(v0[2], v0[3]); w.z = cvt_pk_bf16(v1[0], v1[1]); w.w = cvt_pk_bf16(v1[2], v1[3]);
                    *(u32x4*)(rowp + bj * HALF) = w; } }
    }
};
__device__ __forceinline__ unsigned skey_(float f) { const unsigned u = __float_as_uint(f); return (u & 0x80000000u) ? ~u : (u | 0x80000000u); }
__device__ __forceinline__ unsigned umin_(unsigned a, unsigned b) { return a < b ? a : b; }
__device__ __forceinline__ unsigned umax_(unsigned a, unsigned b) { return a > b ? a : b; }
__device__ __forceinline__ void ins16(unsigned (&L)[16], unsigned x) {
#pragma unroll
    for (int k = 15; k >= 1; --k) { unsigned r; asm("v_med3_u32 %0, %1, %2, %3" : "=v"(r) : "v"(L[k]), "v"(L[k - 1]), "v"(x)); L[k] = r; }
    L[0] = umax_(L[0], x);
}
struct EpiTopK {
    static constexpr bool AFTER_DRAIN = true;
    int* experts; float* gates; const u64* ssx1; const float* csh; unsigned short* exp16;
    __device__ __forceinline__ void fused(const f32x4 (&acc)[2][2][4][2], const Unit& u, int wr, int wc, int fr, int fq, LAS unsigned char* lds, int tid) const {
        constexpr int RS = 272;
        LAS float* S = (LAS float*)lds; LAS unsigned* SU = (LAS unsigned*)lds;
        int t2 = tid; asm volatile("" : "+v"(t2));
        const int r = t2 >> 2, p = (t2 >> 1) & 1, hf = t2 & 1;
        f32x4 cs4[2][2];
#pragma unroll
        for (int bj = 0; bj < 2; ++bj)
#pragma unroll
            for (int n = 0; n < 2; ++n) cs4[bj][n] = *(const f32x4*)(csh + (size_t)(u.pm >> 4) * DM + u.pn * BM + 128 * bj + 32 * wc + 8 * fq + 4 * n);
#pragma unroll
        for (int ai = 0; ai < 2; ++ai) {
#pragma unroll
            for (int m = 0; m < 4; ++m) { const float rstd = rsqrtf(ss_get(ssx1 + u.pm * BM + ai * HALF + 64 * wr + 16 * m + fr) * (1.f / DM) + EPS);
#pragma unroll
                for (int bj = 0; bj < 2; ++bj)
#pragma unroll
                    for (int n = 0; n < 2; ++n) { const int rr = 64 * wr + 16 * m + fr, c = 128 * bj + 32 * wc + 8 * fq + 4 * n; *(LAS f32x4*)(S + rr * RS + c + 4 * (c >> 6)) = acc[ai][bj][m][n] * rstd + cs4[bj][n]; } }
            asm volatile("s_waitcnt lgkmcnt(0)" ::: "memory"); __builtin_amdgcn_s_barrier(); asm volatile("" ::: "memory");
            unsigned L[16];
#pragma unroll
            for (int k = 0; k < 16; ++k) L[k] = 0u;
            { const LAS float* sp = S + r * RS + p * 128 + hf * 64 + 4 * (2 * p + hf);
#pragma unroll 4
              for (int i = 0; i < 16; ++i) { const f32x4 v = *(const LAS f32x4*)(sp + 4 * i);
#pragma unroll
                for (int e = 0; e < 4; ++e) ins16(L, (skey_(v[e]) & 0xFFFFFF80u) | (unsigned)(hf * 64 + 4 * i + e)); } }
            { unsigned P[16];
#pragma unroll
              for (int k = 0; k < 16; ++k) P[k] = __float_as_uint(lx1(__uint_as_float(L[k])));
#pragma unroll
              for (int k = 0; k < 16; ++k) ins16(L, P[k]); }
            float val[16];
#pragma unroll
            for (int k = 0; k < 16; ++k) { const int c = p * 128 + (int)(L[k] & 127u); val[k] = S[r * RS + c + 4 * (c >> 6)]; }
            asm volatile("s_waitcnt lgkmcnt(0)" ::: "memory"); __builtin_amdgcn_wave_barrier();
            if (hf == 0) {
#pragma unroll
                for (int k = 0; k < 16; ++k) { S[r * RS + p * 16 + k] = val[k]; SU[r * RS + 32 + p * 16 + k] = L[k] & 127u; } }
            asm volatile("s_waitcnt lgkmcnt(0)" ::: "memory"); __builtin_amdgcn_wave_barrier();
            if (p == 0 && hf == 0) {
                float s2[16];
#pragma unroll
                for (int k = 0; k < 16; ++k) s2[k] = S[r * RS + 16 + k];
                unsigned C[16];
#pragma unroll
                for (int k = 0; k < 16; ++k) C[k] = 0u;
#pragma unroll
                for (int a_ = 0; a_ < 16; ++a_)
#pragma unroll
                    for (int b_ = 0; b_ < 16; ++b_) if ((a_ + 1) * (b_ + 1) <= 16) ins16(C, (skey_(val[a_] + s2[b_]) & 0xFFFFFF00u) | (unsigned)(a_ * 16 + b_));
                float sv[16]; int ex[16]; float mx = -3.0e38f;
#pragma unroll
                for (int k = 0; k < 16; ++k) { const int a_ = (int)((C[k] >> 4) & 15u), b_ = (int)(C[k] & 15u);
                    sv[k] = S[r * RS + a_] + S[r * RS + 16 + b_]; ex[k] = (int)(SU[r * RS + 32 + a_] * 128u + SU[r * RS + 48 + b_]); mx = fmaxf(mx, sv[k]); }
                float sum = 0.f;
#pragma unroll
                for (int k = 0; k < 16; ++k) { sv[k] = __expf(sv[k] - mx); sum += sv[k]; }
                const float inv = 1.f / sum; const size_t o = (size_t)(u.pm * BM + ai * HALF + r) * 128 + u.pn * 16;
#pragma unroll
                for (int k = 0; k < 16; k += 4) { *(f32x4*)(gates + o + k) = (f32x4){sv[k] * inv, sv[k + 1] * inv, sv[k + 2] * inv, sv[k + 3] * inv};
                    *(u32x4*)(experts + o + k) = (u32x4){(unsigned)ex[k], (unsigned)ex[k + 1], (unsigned)ex[k + 2], (unsigned)ex[k + 3]};
                    *(u32x2*)(exp16 + o + k) = (u32x2){(unsigned)ex[k] | ((unsigned)ex[k + 1] << 16), (unsigned)ex[k + 2] | ((unsigned)ex[k + 3] << 16)}; } }
            asm volatile("s_waitcnt lgkmcnt(0)" ::: "memory"); __builtin_amdgcn_s_barrier(); asm volatile("" ::: "memory"); }
    }
};
#undef EPI_LOOP_HEAD
}

struct Args {
    const float* x; const float* c; const int* pos; const float* ada_w; const float* ada_b; const float* mix_g; const float* w_in; const float* qn_g; const float* w_uq;
    const float* kvn_g; const float* w_ukv; const float* mla_og; const float* w_gate2; const float* b_gate; const float* gla_og; const float* w_out; const float* ffn_g;
    const float* w_q; const float* sub_keys; const float* u_tab; const float* v_tab; const float* fin_g;
    float* out; unsigned char* ws; int ph_lo, ph_hi;
};

constexpr int NTHREADS = 512, NWAVES = 8;
constexpr int LDS_BYTES = 147456;
constexpr int MISC_OFF_PRE = LDS_BYTES - 64 + 16;

typedef const __attribute__((address_space(4))) Args* ArgsP;
__device__ __forceinline__ Args fresh_args() {
#if defined(__HIP_DEVICE_COMPILE__)
    ArgsP p = (ArgsP)__builtin_amdgcn_kernarg_segment_ptr(); asm volatile("" : "+s"(p)); return *p;
#else
    return Args{};
#endif
}

__device__ __forceinline__ int src_col_in(int n) {
    if (n < 768) return n;
    if (n < 1280) return 832 + (n - 768);
    if (n < 1792) return 1344 + (n - 1280);
    if (n < 2816) return 1856 + (n - 1792);
    if (n < 3840) return 2896 + (n - 2816);
    if (n < 3904) { const int j = n - 3840; return 768 + (j & 1) * 32 + (j >> 1); }
    if (n < 3920) return 2880 + (n - 3904);
    return -1;
}
__device__ __forceinline__ int src_col_kv(int n, int o) { return (n >> 7) * 256 + o + (n & 127); }
__device__ __forceinline__ int src_col_uq(int n) { const int hd = n / 192, j = n - hd * 192; if (j < 128) return n; const int jj = j - 128; return hd * 192 + 128 + (jj & 1) * 32 + (jj >> 1); }

__device__ __forceinline__ int kmap_out(int kp) { if (kp >= 1024) return kp; const int w = kp & 127; return (kp & ~127) + (w & 3) * 32 + (w >> 2); }
template <int MAP>
__device__ __forceinline__ void transpose_item(const float* W, int K, int Nsrc, int Ndst, const float* kscale, bf16_t* Bt, float* scr, int item, int lane) {
    const int nblk = Ndst / 32, kb = item / nblk, nb = item % nblk, k0 = 64 * kb, n0 = 32 * nb;
    const int n = n0 + (lane & 31); const int sc = MAP == 1 ? src_col_in(n) : (MAP == 2 ? src_col_uq(n) : (MAP == 4 ? src_col_kv(n, 0) : (MAP == 5 ? src_col_kv(n, 128) : n)));
    const int sc0 = MAP == 1 ? src_col_in(n0) : (MAP == 2 ? src_col_uq(n0) : (MAP == 4 ? src_col_kv(n0, 0) : (MAP == 5 ? src_col_kv(n0, 128) : n0)));
    const int sc31 = MAP == 1 ? src_col_in(n0 + 31) : (MAP == 2 ? src_col_uq(n0 + 31) : (MAP == 4 ? src_col_kv(n0 + 31, 0) : (MAP == 5 ? src_col_kv(n0 + 31, 128) : n0 + 31)));
    if (sc0 >= 0 && sc31 - sc0 == 31 && ((sc0 | Nsrc) & 3) == 0) {
        const int kr = lane >> 3, nq = lane & 7; f32x4 v[8];
#pragma unroll
        for (int i = 0; i < 8; ++i) v[i] = *(const f32x4*)(W + (size_t)(MAP == 3 ? kmap_out(k0 + 8 * i + kr) : k0 + 8 * i + kr) * Nsrc + sc0 + 4 * nq);
#pragma unroll
        for (int i = 0; i < 8; ++i) { const int kk = 8 * i + kr; const float ks = kscale ? kscale[k0 + kk] : 1.f;
            scr[kk * 33 + 4 * nq + 0] = v[i][0] * ks; scr[kk * 33 + 4 * nq + 1] = v[i][1] * ks; scr[kk * 33 + 4 * nq + 2] = v[i][2] * ks; scr[kk * 33 + 4 * nq + 3] = v[i][3] * ks; }
    } else {
#pragma unroll 16
    for (int i = 0; i < 32; ++i) { const int kk = 2 * i + (lane >> 5); float v = 0.f; if (sc >= 0) v = W[(size_t)(MAP == 3 ? kmap_out(k0 + kk) : k0 + kk) * Nsrc + sc]; if (kscale) v *= kscale[k0 + kk]; scr[kk * 33 + (lane & 31)] = v; }
    }
    __builtin_amdgcn_wave_barrier(); asm volatile("s_waitcnt lgkmcnt(0)" ::: "memory");
    const int c = lane & 7;
#pragma unroll
    for (int j = 0; j < 4; ++j) { const int nn = (lane >> 3) + 8 * j; const float* s = scr + (8 * c) * 33 + nn;
        if (MAP == 1 || MAP == 3) { u32x2 o8; o8.x = pk4_fp8(s[0 * 33], s[1 * 33], s[2 * 33], s[3 * 33], FP8_SB); o8.y = pk4_fp8(s[4 * 33], s[5 * 33], s[6 * 33], s[7 * 33], FP8_SB);
            *(u32x2*)((unsigned char*)Bt + (size_t)(n0 + nn) * K + k0 + 8 * c) = o8; continue; }
        u32x4 o; o.x = cvt_pk_bf16(s[0 * 33], s[1 * 33]); o.y = cvt_pk_bf16(s[2 * 33], s[3 * 33]); o.z = cvt_pk_bf16(s[4 * 33], s[5 * 33]); o.w = cvt_pk_bf16(s[6 * 33], s[7 * 33]);
        *(u32x4*)(Bt + (size_t)(n0 + nn) * K + k0 + 8 * c) = o; }
    __builtin_amdgcn_wave_barrier(); asm volatile("s_waitcnt lgkmcnt(0)" ::: "memory");
}

__device__ __forceinline__ void phase_p0(const int tid, const Args& a, char* lds, const bool do_mod) {
    const int lane = tid & 63, wave = __builtin_amdgcn_readfirstlane(tid >> 6), bx = blockIdx.x, G = gridDim.x;
    unsigned char* ws = a.ws;
    { float* cact = (float*)lds;
      u64* modz = (u64*)(ws + WS_CTL + CTL_MODZI);
      for (int it = do_mod ? bx : 256; it < 256; it += G) { const int cgp = it & 7, kg = it >> 3;
        __syncthreads();
        if (tid < 256) { const int bt = tid >> 6, kk = tid & 63; const float cv = a.c[bt * DM + kg * 64 + kk]; cact[tid] = cv / (1.f + __expf(-cv)); }
        __syncthreads();
        if (tid < 384) { const int col = cgp * 1536 + 4 * tid; f32x4 ac[4] = {};
            const float* wp = a.ada_w + (size_t)(kg * 64) * NMOD + col;
#pragma unroll 16
            for (int kk = 0; kk < 64; ++kk) { const f32x4 w = *(const f32x4*)(wp + (size_t)kk * NMOD);
#pragma unroll
                for (int bt = 0; bt < 4; ++bt) ac[bt] += w * cact[bt * 64 + kk]; }
#pragma unroll
            for (int bt = 0; bt < 4; ++bt)
#pragma unroll
                for (int q = 0; q < 4; ++q) mz_add(modz + (size_t)bt * NMOD + col + q, ac[bt][q]); }
      }
      __syncthreads(); }
    { float* scr = (float*)(lds + wave * 8448);
      const int gw = bx * NWAVES + wave, NGW = G * NWAVES;
      constexpr int I_IN = 32 * 128, I_UQ = 8 * 48, I_UKV = 2 * 4 * 32, I_OUT = 32 * 64;
      for (int it = gw; it < I_IN + I_UQ + I_UKV + I_OUT; it += NGW) { int r = it;
        if (r < I_IN) { transpose_item<1>(a.w_in, 2048, 3920, 4096, nullptr, (bf16_t*)(ws + WS_BTIN), scr, r, lane); continue; } r -= I_IN;
        if (r < I_UQ) { transpose_item<2>(a.w_uq, 512, 1536, 1536, a.qn_g, (bf16_t*)(ws + WS_BTUQ), scr, r, lane); continue; } r -= I_UQ;
        if (r < I_UKV) { if (r < 128) transpose_item<4>(a.w_ukv, 256, 2048, 1024, a.kvn_g, (bf16_t*)(ws + WS_BTK), scr, r, lane); else transpose_item<5>(a.w_ukv, 256, 2048, 1024, a.kvn_g, (bf16_t*)(ws + WS_BTV), scr, r - 128, lane); continue; } r -= I_UKV;
        transpose_item<3>(a.w_out, 2048, 2048, 2048, nullptr, (bf16_t*)(ws + WS_BTOUT), scr, r, lane); } }
    __syncthreads();
    { const int gw = bx * NWAVES + wave, NGW = G * NWAVES, fr = lane & 15, fq = lane >> 4; bf16_t* bte = (bf16_t*)(ws + WS_BTQ);
#define SPLIT8(P_, HI_, LO_) do { const f32x4 x0_ = *(const f32x4*)(P_), x1_ = *(const f32x4*)((P_) + 4); const float xs_[8] = {x0_[0], x0_[1], x0_[2], x0_[3], x1_[0], x1_[1], x1_[2], x1_[3]}; u32x4 h_, l_; \
        _Pragma("unroll") for (int q_ = 0; q_ < 4; ++q_) { const unsigned hp_ = cvt_pk_bf16(xs_[2 * q_], xs_[2 * q_ + 1]); h_[q_] = hp_; \
            l_[q_] = cvt_pk_bf16(xs_[2 * q_] - __uint_as_float(hp_ << 16), xs_[2 * q_ + 1] - __uint_as_float(hp_ & 0xffff0000u)); } \
        HI_ = __builtin_bit_cast(bf16x8, h_); LO_ = __builtin_bit_cast(bf16x8, l_); } while (0)
      for (int it = gw; it < 64 * 32; it += NGW) { const int nb = it >> 5, kb = it & 31, n0 = nb * 32, k0 = kb * 64, hp = n0 >> 7;
        f32x4 acc[2][4];
#pragma unroll
        for (int na = 0; na < 2; ++na)
#pragma unroll
            for (int kt = 0; kt < 4; ++kt) acc[na][kt] = (f32x4){0.f, 0.f, 0.f, 0.f};
#pragma unroll
        for (int ks = 0; ks < 4; ++ks) { bf16x8 ah[2], al[2];
#pragma unroll
            for (int na = 0; na < 2; ++na) { const float* p = a.sub_keys + (size_t)(n0 + 16 * na + fr) * 128 + 32 * ks + 8 * fq; SPLIT8(p, ah[na], al[na]); }
#pragma unroll
            for (int kt = 0; kt < 4; ++kt) { const float* p = a.w_q + (size_t)(k0 + 16 * kt + fr) * 2048 + hp * 128 + 32 * ks + 8 * fq; bf16x8 bh, bl; SPLIT8(p, bh, bl);
#pragma unroll
                for (int na = 0; na < 2; ++na) { acc[na][kt] = __builtin_amdgcn_mfma_f32_16x16x32_bf16(ah[na], bh, acc[na][kt], 0, 0, 0);
                    acc[na][kt] = __builtin_amdgcn_mfma_f32_16x16x32_bf16(ah[na], bl, acc[na][kt], 0, 0, 0); acc[na][kt] = __builtin_amdgcn_mfma_f32_16x16x32_bf16(al[na], bh, acc[na][kt], 0, 0, 0); } } }
#pragma unroll
        for (int na = 0; na < 2; ++na)
#pragma unroll
            for (int kt = 0; kt < 4; ++kt)
#pragma unroll
                for (int r = 0; r < 4; ++r) { const float v = acc[na][kt][r], vn = lx1(v);
                    if ((fr & 1) == 0) *(unsigned*)(bte + (size_t)(n0 + 16 * na + 4 * fq + r) * 2048 + k0 + 16 * kt + fr) = cvt_pk_bf16(v, vn); } }
#undef SPLIT8
    }
    { const int gt = bx * NTHREADS + tid, NGT = G * NTHREADS;
      f32x2* cs = (f32x2*)(ws + WS_CS);
      for (int i = gt; i < NTOK * 32; i += NGT) { const int tok = i >> 5, fi = i & 31;
        const float inv_freq = __builtin_amdgcn_exp2f(-(float)(2 * fi) * (13.287712379549449f / 64.f)); const float ang = (float)a.pos[tok] * inv_freq;
        const double rev = (double)ang * 0.15915494309189535; const float fr = (float)(rev - rint(rev));
        cs[i] = (f32x2){__builtin_amdgcn_cosf(fr), __builtin_amdgcn_sinf(fr)}; } }
}

template <bool SECOND>
__device__ __forceinline__ void phase_rows(const int tid, const Args& a) {
    const int lane = tid & 63, wave = __builtin_amdgcn_readfirstlane(tid >> 6), gw = blockIdx.x * NWAVES + wave, NGW = gridDim.x * NWAVES;
    const float* modz = (const float*)(a.ws + WS_CTL + CTL_MODZ); const u64* modzi = (const u64*)(a.ws + WS_CTL + CTL_MODZI); const u64* ssx1 = (const u64*)(a.ws + WS_CTL + CTL_SSX1);
    if (!SECOND) { float* mf = (float*)(a.ws + WS_CTL + CTL_MODZ);
        for (int i = blockIdx.x * NTHREADS + tid; i < 4 * NMOD; i += gridDim.x * NTHREADS) mf[i] = mz_get(modzi + i); }
    const float* xin = SECOND ? a.out : a.x; const float* gain = SECOND ? a.ffn_g : a.mix_g; bf16_t* hb = (bf16_t*)(a.ws + WS_HBUF);
    constexpr int OSH = SECOND ? MOD_SH2 : MOD_SH1, OSC = SECOND ? MOD_SC2 : MOD_SC1;
    for (int grp = gw; grp < NTOK / 8; grp += NGW) { const int row0 = grp * 8, b = row0 >> 12;
        f32x4 gm[8], sh[8];
#pragma unroll
        for (int j = 0; j < 8; ++j) { const int col = 256 * j + 4 * lane;
            f32x4 zc, zh;
            if (SECOND) { zc = *(const f32x4*)(modz + (size_t)b * NMOD + OSC + col); zh = *(const f32x4*)(modz + (size_t)b * NMOD + OSH + col); }
            else {
#pragma unroll
                for (int q = 0; q < 4; ++q) { zc[q] = mz_get(modzi + (size_t)b * NMOD + OSC + col + q); zh[q] = mz_get(modzi + (size_t)b * NMOD + OSH + col + q); } }
            const f32x4 g = *(const f32x4*)(gain + col), sc = zc + *(const f32x4*)(a.ada_b + OSC + col);
            gm[j] = g * (sc + 1.f); sh[j] = zh + *(const f32x4*)(a.ada_b + OSH + col); }
        f32x4 va[8], vb[8];
#pragma unroll
        for (int j = 0; j < 8; ++j) va[j] = __builtin_nontemporal_load((const f32x4*)(xin + (size_t)row0 * DM + 4 * lane + 256 * j));
#pragma unroll
        for (int j = 0; j < 8; ++j) vb[j] = __builtin_nontemporal_load((const f32x4*)(xin + (size_t)(row0 + 1) * DM + 4 * lane + 256 * j));
#define ROWSTEP(VB, r_) do { const int r = (r_), row = row0 + r; \
            f32x4 v[8]; float s = 0.f; \
            _Pragma("unroll") for (int j = 0; j < 8; ++j) { v[j] = VB[j]; s += v[j][0] * v[j][0] + v[j][1] * v[j][1] + v[j][2] * v[j][2] + v[j][3] * v[j][3]; } \
            { const int rn = r + 2 < 8 ? row + 2 : row;                                   \
              _Pragma("unroll") for (int j = 0; j < 8; ++j) VB[j] = __builtin_nontemporal_load((const f32x4*)(xin + (size_t)rn * DM + 4 * lane + 256 * j)); } \
            float tot; if (SECOND) tot = ss_get(ssx1 + row); else tot = wave_sum(s); \
            const float rstd = rsqrtf(tot * (1.f / DM) + EPS); \
            bf16_t* op = hb + (size_t)row * DM + 4 * lane; \
            _Pragma("unroll") for (int j = 0; j < 8; ++j) { const f32x4 o = v[j] * rstd * gm[j] + sh[j]; \
                if (!SECOND) *(unsigned*)((unsigned char*)hb + (size_t)row * DM + 4 * lane + 256 * j) = pk4_fp8(o[0], o[1], o[2], o[3], FP8_SA);     \
                else { u32x2 w; w.x = cvt_pk_bf16(o[0], o[1]); w.y = cvt_pk_bf16(o[2], o[3]); *(u32x2*)(op + 256 * j) = w; } } } while (0)
#pragma unroll 1
        for (int r2 = 0; r2 < 8; r2 += 2) { ROWSTEP(va, r2); ROWSTEP(vb, r2 + 1); }
#undef ROWSTEP
    }
}
__device__ __forceinline__ void phase_tables(const int tid, const Args& a, char* lds) {
    const int lane = tid & 63, gw = blockIdx.x * NWAVES + __builtin_amdgcn_readfirstlane(tid >> 6), NGW = gridDim.x * NWAVES;
    unsigned char* ub = a.ws + WS_UTAB; unsigned char* vb = a.ws + WS_VTAB; float* usc = (float*)(a.ws + WS_USC); float* vsc = (float*)(a.ws + WS_VSC); float* ush = (float*)(a.ws + WS_USH); float* sc4 = (float*)(a.ws + WS_SC4); (void)usc; (void)vsc; (void)ush;
    float* sh2 = (float*)lds; const float* modz = (const float*)(a.ws + WS_CTL + CTL_MODZ);
    __syncthreads();
    for (int i = tid; i < 4 * DM / 4; i += NTHREADS) { const int b = i >> 9, c = 4 * (i & 511); *(f32x4*)(sh2 + b * DM + c) = *(const f32x4*)(modz + (size_t)b * NMOD + MOD_SH2 + c) + *(const f32x4*)(a.ada_b + MOD_SH2 + c); }
    __syncthreads();
    { const bf16_t* wt = (const bf16_t*)(a.ws + WS_BTQ); float* csh = (float*)(a.ws + WS_CSH);
      for (int n = gw; n < DM; n += NGW) { float d[4] = {0.f, 0.f, 0.f, 0.f};
#pragma unroll
        for (int j = 0; j < 4; ++j) { const int k = 512 * j + 8 * lane; const u32x4 w = *(const u32x4*)(wt + (size_t)n * DM + k);
            const float wf[8] = {bf_lo(w.x), bf_hi(w.x), bf_lo(w.y), bf_hi(w.y), bf_lo(w.z), bf_hi(w.z), bf_lo(w.w), bf_hi(w.w)};
#pragma unroll
            for (int b = 0; b < 4; ++b) { const f32x4 s0 = *(const f32x4*)(sh2 + b * DM + k), s1 = *(const f32x4*)(sh2 + b * DM + k + 4);
                d[b] += wf[0] * s0[0] + wf[1] * s0[1] + wf[2] * s0[2] + wf[3] * s0[3] + wf[4] * s1[0] + wf[5] * s1[1] + wf[6] * s1[2] + wf[7] * s1[3]; } }
#pragma unroll
        for (int b = 0; b < 4; ++b) { const float t = wave_sum(d[b]); if (lane == 0) csh[b * DM + n] = t; } } }
#define TB_LOAD(V, r_) do { const int rr_ = (r_) < 2 * 16384 ? (r_) : 2 * 16384 - 1; const float* src = (rr_ >= 16384 ? a.v_tab + (size_t)(rr_ - 16384) * DM : a.u_tab + (size_t)rr_ * DM) + 4 * lane; \
        _Pragma("unroll") for (int j = 0; j < 2; ++j) _Pragma("unroll") for (int q = 0; q < 4; ++q) V[j][q] = __builtin_nontemporal_load((const f32x4*)(src + 256 * (4 * j + q))); } while (0)
#define TB_STORE(V, r) do { const bool second = (r) >= 16384; const int row = second ? (r) - 16384 : (r); float mx = 0.f; \
        _Pragma("unroll") for (int j = 0; j < 2; ++j) _Pragma("unroll") for (int q = 0; q < 4; ++q) mx = fmaxf(mx, fmaxf(fmaxf(fabsf(V[j][q][0]), fabsf(V[j][q][1])), fmaxf(fabsf(V[j][q][2]), fabsf(V[j][q][3])))); \
        mx = fmaxf(mx, lx1(mx)); mx = fmaxf(mx, lx2(mx)); mx = fmaxf(mx, lx7(mx)); mx = fmaxf(mx, lx8(mx)); mx = fmaxf(mx, lx16(mx, lane)); mx = fmaxf(mx, lx32(mx, lane)); \
        int e = (int)((__float_as_uint(mx) >> 23) & 0xffu) - 127; if (mx == 0.f) e = 7; if (e < -100) e = -100; if (e > 100) e = 100; \
        const float sc = __uint_as_float((unsigned)(127 + 7 - e) << 23), inv = __uint_as_float((unsigned)(127 - 7 + e) << 23); \
        unsigned char* tb = (second ? vb : ub); \
        _Pragma("unroll") for (int j = 0; j < 2; ++j) \
            _Pragma("unroll") for (int q = 0; q < 4; ++q) { int p = __builtin_amdgcn_cvt_pk_fp8_f32(V[j][q][0] * sc, V[j][q][1] * sc, 0, false); p = __builtin_amdgcn_cvt_pk_fp8_f32(V[j][q][2] * sc, V[j][q][3] * sc, p, true); \
                *(unsigned*)(tb + ((size_t)(2 * (4 * j + q) + (lane >> 5)) * 16384 + row) * 128 + 4 * (lane & 31)) = (unsigned)p; }     \
        if (lane < 4) sc4[((size_t)lane * 16384 + row) * 4 + (second ? 1 : 0)] = inv;     \
        if (!second) { f32x2 d2[4] = {{0.f, 0.f}, {0.f, 0.f}, {0.f, 0.f}, {0.f, 0.f}};     \
            _Pragma("unroll") for (int j = 0; j < 2; ++j) _Pragma("unroll") for (int q = 0; q < 4; ++q) _Pragma("unroll") for (int b = 0; b < 4; ++b) { const f32x4 s4 = *(const f32x4*)(sh2 + b * DM + 256 * (4 * j + q) + 4 * lane); \
                d2[b] += (f32x2){V[j][q][0], V[j][q][1]} * (f32x2){s4[0], s4[1]}; d2[b] += (f32x2){V[j][q][2], V[j][q][3]} * (f32x2){s4[2], s4[3]}; } \
            _Pragma("unroll") for (int b = 0; b < 4; ++b) { const float t = wave_sum(d2[b][0] + d2[b][1]); if (lane == 0) sc4[((size_t)b * 16384 + row) * 4 + 2] = t; } } } while (0)
#define TB_ROW(q_) (8 * (gw + ((q_) >> 3) * NGW) + ((q_) & 7))
    f32x4 va[2][4], vb2[2][4];
    TB_LOAD(va, TB_ROW(0));
#pragma unroll 1
    for (int q = 0; TB_ROW(q) < 2 * 16384; q += 2) { const int ra = TB_ROW(q), rb = TB_ROW(q + 1);
        TB_LOAD(vb2, rb);
        TB_STORE(va, ra);
        TB_LOAD(va, TB_ROW(q + 2));
        TB_STORE(vb2, rb); }
#undef TB_ROW
#undef TB_LOAD
#undef TB_STORE
}

__device__ __forceinline__ void phase_kpe(const int tid, const Args& a) {
    const int gt = blockIdx.x * NTHREADS + tid, NGT = gridDim.x * NTHREADS;
    const bf16_t* proj = (const bf16_t*)(a.ws + WS_PROJ); const f32x2* cs = (const f32x2*)(a.ws + WS_CS); unsigned short* kp = (unsigned short*)(a.ws + WS_KPE);
    for (int i = gt; i < NTOK * 32; i += NGT) { const int tok = i >> 5, fi = i & 31; const unsigned w = *(const unsigned*)(proj + (size_t)tok * NPROJ + PJ_KPE + 2 * fi);
        const float x1 = bf_lo(w), x2 = bf_hi(w); const f32x2 c = cs[i]; kp[i] = (unsigned short)(pk4_fp8(x1 * c[0] - x2 * c[1], x2 * c[0] + x1 * c[1], 0.f, 0.f, FP8_SK) & 0xffffu); }
}

__device__ __forceinline__ bf16x8 ldsfrag(const char* base, int row, int ldb_bytes, int kbyte) { return *(const bf16x8*)(base + row * ldb_bytes + kbyte); }

namespace gla {
constexpr int L_BC = 0, L_SEG = 32768, L_GLR = 34816;
constexpr int A_KDT = 38912, A_VT = 57344;
constexpr int C_QE = 38912, C_KE = 56320, C_QB = 73728, C_VT = 91136, C_AM = 128000, C_PART = 137216, C_RS = 139264;
constexpr int LD72 = 144, LD136 = 272;

__device__ __forceinline__ float logsig(float z) { return fminf(z, 0.f) - __logf(1.f + __expf(-fabsf(z))); }

__device__ __forceinline__ void build_bcum(const int tid, char* lds, const unsigned glw, const float (&w2r)[16], const float bg) {
    float* BC = (float*)(lds + L_BC); float* SEG = (float*)(lds + L_SEG); float* GLR = (float*)(lds + L_GLR);
    { const int idx = tid * 2; GLR[idx] = bf_lo(glw); GLR[idx + 1] = bf_hi(glw); }
    __syncthreads();
    const int d = tid & 127, iq = tid >> 7;
    float run = 0.f;
#pragma unroll 2
    for (int ii = 0; ii < 16; ++ii) { const int i = iq * 16 + ii; float z = bg;
#pragma unroll
        for (int r4 = 0; r4 < 4; ++r4) { const f32x4 gl = *(const f32x4*)(GLR + i * 16 + 4 * r4); z += gl[0] * w2r[4 * r4] + gl[1] * w2r[4 * r4 + 1] + gl[2] * w2r[4 * r4 + 2] + gl[3] * w2r[4 * r4 + 3]; }
        run += logsig(z) * (1.f / 16.f); BC[i * 128 + d] = run; }
    SEG[iq * 128 + d] = run;
    __syncthreads();
    float off = 0.f;
#pragma unroll 1
    for (int q = 0; q < iq; ++q) off += SEG[q * 128 + d];
#pragma unroll 4
    for (int ii = 0; ii < 16; ++ii) BC[(iq * 16 + ii) * 128 + d] += off;
    __syncthreads();
}
__device__ __forceinline__ void build_vt(const int tid, char* lds, int off_vt, const bf16_t* proj, int t0, int hd) {
    const int c = tid & 255, g = tid >> 8;
#pragma unroll
    for (int p = 0; p < 4; ++p) { const int i0 = g * 32 + p * 8; unsigned short e[8];
#pragma unroll
        for (int q = 0; q < 8; ++q) e[q] = proj[(size_t)(t0 + i0 + q) * NPROJ + PJ_GV + hd * 256 + c];
        u32x4 w; w.x = e[0] | ((unsigned)e[1] << 16); w.y = e[2] | ((unsigned)e[3] << 16); w.z = e[4] | ((unsigned)e[5] << 16); w.w = e[6] | ((unsigned)e[7] << 16);
        *(u32x4*)(lds + off_vt + c * LD72 + i0 * 2) = w; }
}

constexpr size_t G_AM = WS_GLAU, G_QB = WS_GLAU + 8 * MiB, G_KDT = WS_GLAU + 24 * MiB, G_VT = WS_GLAU + 40 * MiB, G_ORAW = WS_GLAU + 72 * MiB;
constexpr int P_QE = 38912, P_KE = 56320, P_QB = 73728, P_KDT = 91136, P_VT = 109568, P_AM = 0;

__device__ __forceinline__ void phase_pre(const int tid, const Args& a, char* lds) {
    const int lane = tid & 63, wave = __builtin_amdgcn_readfirstlane(tid >> 6), fr = lane & 15, fq = lane >> 4;
    const bf16_t* proj = (const bf16_t*)(a.ws + WS_PROJ); float* decay = (float*)(a.ws + WS_DECAY);
    bf16_t* AMg = (bf16_t*)(a.ws + G_AM); bf16_t* QBg = (bf16_t*)(a.ws + G_QB); bf16_t* KDTg = (bf16_t*)(a.ws + G_KDT); bf16_t* VTg = (bf16_t*)(a.ws + G_VT);
    unsigned* qh = (unsigned*)(a.ws + WS_CTL + CTL_QUEUE) + 64 * 96; volatile unsigned* qs = (volatile unsigned*)(lds + MISC_OFF_PRE);
    if (tid == 0) qs[0] = __hip_atomic_fetch_add(qh, 1u, __ATOMIC_RELAXED, __HIP_MEMORY_SCOPE_AGENT);
    __syncthreads(); int ch = __builtin_amdgcn_readfirstlane((int)qs[0]); __syncthreads();
    for (;;) {
        if (ch >= 1024) break;
        unsigned nxt = 0u; if (tid == 0) nxt = __hip_atomic_fetch_add(qh, 1u, __ATOMIC_RELAXED, __HIP_MEMORY_SCOPE_AGENT);
        const int bh = ch >> 6, n = ch & 63, b = bh >> 2, hd = bh & 3, t0 = b * SEQ + n * 64;
        unsigned glw; float w2r[16], bg;
        { const int idx = tid * 2, i = idx >> 4, r = idx & 15, d = tid & 127; glw = *(const unsigned*)(proj + (size_t)(t0 + i) * NPROJ + PJ_GLR + r);
#pragma unroll
          for (int r2 = 0; r2 < 16; ++r2) w2r[r2] = a.w_gate2[r2 * 512 + hd * 128 + d];
          bg = a.b_gate[hd * 128 + d]; }
        __builtin_amdgcn_sched_barrier(0);
        unsigned qraw[16], kraw[16], vraw[32];
        { const unsigned d2 = 2u * (unsigned)(tid & 127), c2 = 2u * (unsigned)(tid & 255); const int g = __builtin_amdgcn_readfirstlane(tid >> 7), g2 = __builtin_amdgcn_readfirstlane(tid >> 8);
#pragma unroll
          for (int q = 0; q < 16; ++q) { const char* rq_ = (const char*)(proj + (size_t)(t0 + g * 16 + q) * NPROJ + PJ_GQ + hd * 128); const char* rk_ = (const char*)(proj + (size_t)(t0 + g * 16 + q) * NPROJ + PJ_GK + hd * 128);
              qraw[q] = *(const unsigned short*)(rq_ + d2); kraw[q] = *(const unsigned short*)(rk_ + d2); }
#pragma unroll
          for (int q = 0; q < 32; ++q) { const char* rv_ = (const char*)(proj + (size_t)(t0 + g2 * 32 + q) * NPROJ + PJ_GV + hd * 256); vraw[q] = *(const unsigned short*)(rv_ + c2); } }
        __builtin_amdgcn_sched_barrier(0);
        build_bcum(tid, lds, glw, w2r, bg);
        const float* BC = (const float*)(lds + L_BC);
        { const int d = tid & 127, g = tid >> 7; const float bmid = BC[31 * 128 + d], blast = BC[63 * 128 + d];
          bf16_t* QE = (bf16_t*)(lds + P_QE); bf16_t* KE = (bf16_t*)(lds + P_KE); bf16_t* QB = (bf16_t*)(lds + P_QB);
          const float emid = __expf(bmid), elast = __expf(blast - bmid);
          if (g == 0) decay[ch * 128 + d] = __expf(blast);
#pragma unroll
          for (int p = 0; p < 2; ++p) { float kd[8];
#pragma unroll
            for (int q = 0; q < 8; ++q) { const int i = g * 16 + p * 8 + q; const float bc = BC[i * 128 + d];
                const float qv = __uint_as_float(qraw[p * 8 + q] << 16) * GLA_QS, kv = __uint_as_float(kraw[p * 8 + q] << 16);
                const float e1 = __expf(bc - bmid), qe_ = qv * e1, ke_ = kv * __builtin_amdgcn_rcpf(e1);
                QE[i * 136 + d] = f2bf(qe_); KE[i * 136 + d] = f2bf(ke_); QB[i * 136 + d] = f2bf(qe_ * emid); kd[q] = ke_ * elast; }
            u32x4 w; w.x = cvt_pk_bf16(kd[0], kd[1]); w.y = cvt_pk_bf16(kd[2], kd[3]); w.z = cvt_pk_bf16(kd[4], kd[5]); w.w = cvt_pk_bf16(kd[6], kd[7]);
            *(u32x4*)(lds + P_KDT + d * LD72 + (g * 16 + p * 8) * 2) = w; } }
        { const int c = tid & 255, g2 = tid >> 8;
#pragma unroll
          for (int p = 0; p < 4; ++p) { u32x4 w; w.x = vraw[8 * p] | (vraw[8 * p + 1] << 16); w.y = vraw[8 * p + 2] | (vraw[8 * p + 3] << 16); w.z = vraw[8 * p + 4] | (vraw[8 * p + 5] << 16); w.w = vraw[8 * p + 6] | (vraw[8 * p + 7] << 16);
              *(u32x4*)(lds + P_VT + c * LD72 + (g2 * 32 + p * 8) * 2) = w; } }
        __syncthreads();
        { const int jt = wave & 3;
#pragma unroll
          for (int il = 0; il < 2; ++il) { const int it = (wave >> 2) * 2 + il; f32x4 acc = {0.f, 0.f, 0.f, 0.f};
#pragma unroll
            for (int ks = 0; ks < 4; ++ks) acc = __builtin_amdgcn_mfma_f32_16x16x32_bf16(ldsfrag(lds + P_KE, jt * 16 + fr, LD136, ks * 64 + fq * 16), ldsfrag(lds + P_QE, it * 16 + fr, LD136, ks * 64 + fq * 16), acc, 0, 0, 0);
            const int i = it * 16 + fr, j0 = jt * 16 + 4 * fq;
            u32x2 w; w.x = cvt_pk_bf16(j0 <= i ? acc[0] : 0.f, j0 + 1 <= i ? acc[1] : 0.f); w.y = cvt_pk_bf16(j0 + 2 <= i ? acc[2] : 0.f, j0 + 3 <= i ? acc[3] : 0.f);
            *(u32x2*)(lds + P_AM + i * LD72 + j0 * 2) = w; } }
        __syncthreads();
        { const int row = tid >> 3, c16 = tid & 7; *(u32x4*)(AMg + (size_t)ch * 4096 + row * 64 + c16 * 8) = *(const u32x4*)(lds + P_AM + row * LD72 + c16 * 16); }
#pragma unroll
        for (int k = 0; k < 2; ++k) { const int idx = tid + 512 * k;
            { const int row = idx >> 4, c16 = idx & 15; *(u32x4*)(QBg + (size_t)ch * 8192 + row * 128 + c16 * 8) = *(const u32x4*)(lds + P_QB + row * LD136 + c16 * 16); }
            { const int row = idx >> 3, c16 = idx & 7; *(u32x4*)(KDTg + (size_t)ch * 8192 + row * 64 + c16 * 8) = *(const u32x4*)(lds + P_KDT + row * LD72 + c16 * 16); } }
#pragma unroll
        for (int k = 0; k < 4; ++k) { const int idx = tid + 512 * k, row = idx >> 3, c16 = idx & 7; *(u32x4*)(VTg + (size_t)ch * 16384 + row * 64 + c16 * 8) = *(const u32x4*)(lds + P_VT + row * LD72 + c16 * 16); }
        if (tid == 0) qs[0] = nxt;
        __syncthreads(); ch = __builtin_amdgcn_readfirstlane((int)qs[0]); __syncthreads(); }
}

constexpr int Q_AM = 0, Q_QB = 9216, Q_KDT = 26624, Q_VT = 45056, Q_ST = 63488, Q_DEC = 98304;
__device__ __forceinline__ void phase_seq(const int tid, const Args& a, char* lds) {
    const int lane = tid & 63, wave = __builtin_amdgcn_readfirstlane(tid >> 6), fr = lane & 15, fq = lane >> 4;
    const float* decay = (const float*)(a.ws + WS_DECAY); bf16_t* oraw = (bf16_t*)(a.ws + G_ORAW);
    const bf16_t* AMg = (const bf16_t*)(a.ws + G_AM); const bf16_t* QBg = (const bf16_t*)(a.ws + G_QB); const bf16_t* KDTg = (const bf16_t*)(a.ws + G_KDT); const bf16_t* VTg = (const bf16_t*)(a.ws + G_VT);
    for (int item = blockIdx.x; item < 32; item += gridDim.x) { const int bh = item >> 1, hs = item & 1, b = bh >> 2, hd = bh & 3;
        f32x4 accS[8];
#pragma unroll
        for (int dt = 0; dt < 8; ++dt) accS[dt] = (f32x4){0.f, 0.f, 0.f, 0.f};
        u32x2 zz; asm volatile("v_mov_b32 %0, 0\n\tv_mov_b32 %1, 0" : "=v"(zz.x), "=v"(zz.y));
#pragma unroll
        for (int dt = 0; dt < 8; ++dt) *(u32x2*)(lds + Q_ST + (16 * wave + fr) * LD136 + (16 * dt + 4 * fq) * 2) = zz;
        u32x4 ram[2], rqb[2][2], rkd[2][2], rvt[2][2]; f32x4 rdc[2];
#define SQ_LOAD(S_, n_) do { const size_t ch_ = (size_t)bh * 64 + (n_); { const int row = tid >> 3, c16 = tid & 7; ram[S_] = *(const u32x4*)(AMg + ch_ * 4096 + row * 64 + c16 * 8); } \
        _Pragma("unroll") for (int k = 0; k < 2; ++k) { const int idx = tid + 512 * k; rqb[S_][k] = *(const u32x4*)(QBg + ch_ * 8192 + (idx >> 4) * 128 + (idx & 15) * 8); rkd[S_][k] = *(const u32x4*)(KDTg + ch_ * 8192 + (idx >> 3) * 64 + (idx & 7) * 8); \
            rvt[S_][k] = *(const u32x4*)(VTg + ch_ * 16384 + (hs * 128 + (idx >> 3)) * 64 + (idx & 7) * 8); } \
        if (tid < 32) rdc[S_] = *(const f32x4*)(decay + ch_ * 128 + 4 * tid); } while (0)
#define SQ_WRITE(S_) do { { const int row = tid >> 3, c16 = tid & 7; *(u32x4*)(lds + Q_AM + row * LD72 + c16 * 16) = ram[S_]; } \
        _Pragma("unroll") for (int k = 0; k < 2; ++k) { const int idx = tid + 512 * k; *(u32x4*)(lds + Q_QB + (idx >> 4) * LD136 + (idx & 15) * 16) = rqb[S_][k]; *(u32x4*)(lds + Q_KDT + (idx >> 3) * LD72 + (idx & 7) * 16) = rkd[S_][k]; \
            *(u32x4*)(lds + Q_VT + (idx >> 3) * LD72 + (idx & 7) * 16) = rvt[S_][k]; } \
        if (tid < 32) *(f32x4*)(lds + Q_DEC + 16 * tid) = rdc[S_]; } while (0)
#define SQ_STEP(n_, SL_, SW_) do { const int n = (n_); \
            SQ_LOAD(SL_, (n + 2 < 64 ? n + 2 : n));                                                            \
            const int crow = 16 * wave + fr;                                                                   \
            const bf16x8 v0 = ldsfrag(lds + Q_VT, crow, LD72, fq * 16), v1 = ldsfrag(lds + Q_VT, crow, LD72, 64 + fq * 16); \
            bf16x8 sf[4]; \
            _Pragma("unroll") for (int ks = 0; ks < 4; ++ks) sf[ks] = ldsfrag(lds + Q_ST, crow, LD136, ks * 64 + fq * 16); \
            _Pragma("unroll") for (int it = 0; it < 4; ++it) { f32x4 acc = {0.f, 0.f, 0.f, 0.f}; const int irow = 16 * it + fr;     \
                acc = __builtin_amdgcn_mfma_f32_16x16x32_bf16(v0, ldsfrag(lds + Q_AM, irow, LD72, fq * 16), acc, 0, 0, 0); \
                acc = __builtin_amdgcn_mfma_f32_16x16x32_bf16(v1, ldsfrag(lds + Q_AM, irow, LD72, 64 + fq * 16), acc, 0, 0, 0); \
                _Pragma("unroll") for (int ks = 0; ks < 4; ++ks) acc = __builtin_amdgcn_mfma_f32_16x16x32_bf16(sf[ks], ldsfrag(lds + Q_QB, irow, LD136, ks * 64 + fq * 16), acc, 0, 0, 0); \
                u32x2 w; w.x = cvt_pk_bf16(acc[0], acc[1]); w.y = cvt_pk_bf16(acc[2], acc[3]); \
                *(u32x2*)(oraw + (size_t)(b * SEQ + n * 64 + irow) * 1024 + hd * 256 + hs * 128 + 16 * wave + 4 * fq) = w; } \
            _Pragma("unroll") for (int dt = 0; dt < 8; ++dt) { const f32x4 dec = *(const f32x4*)(lds + Q_DEC + (16 * dt + 4 * fq) * 4);     \
                accS[dt] = accS[dt] * dec; \
                accS[dt] = __builtin_amdgcn_mfma_f32_16x16x32_bf16(ldsfrag(lds + Q_KDT, 16 * dt + fr, LD72, fq * 16), v0, accS[dt], 0, 0, 0); \
                accS[dt] = __builtin_amdgcn_mfma_f32_16x16x32_bf16(ldsfrag(lds + Q_KDT, 16 * dt + fr, LD72, 64 + fq * 16), v1, accS[dt], 0, 0, 0); } \
            __syncthreads();                                                                                   \
            _Pragma("unroll") for (int dt = 0; dt < 8; ++dt) { u32x2 w; w.x = cvt_pk_bf16(accS[dt][0], accS[dt][1]); w.y = cvt_pk_bf16(accS[dt][2], accS[dt][3]); *(u32x2*)(lds + Q_ST + crow * LD136 + (16 * dt + 4 * fq) * 2) = w; } \
            if (n + 1 < 64) SQ_WRITE(SW_); \
            __syncthreads(); } while (0)
        SQ_LOAD(0, 0); SQ_WRITE(0);
        __syncthreads();
        SQ_LOAD(0, 1);
#pragma unroll 1
        for (int n2 = 0; n2 < 64; n2 += 2) { SQ_STEP(n2, 1, 0); SQ_STEP(n2 + 1, 0, 1); }
#undef SQ_STEP
#undef SQ_LOAD
#undef SQ_WRITE
    }
}
__device__ __forceinline__ void phase_post(const int tid, const Args& a) {
    const int lane = tid & 63, gw = blockIdx.x * NWAVES + __builtin_amdgcn_readfirstlane(tid >> 6), NGW = gridDim.x * NWAVES;
    const bf16_t* oraw = (const bf16_t*)(a.ws + G_ORAW); const bf16_t* proj = (const bf16_t*)(a.ws + WS_PROJ); bf16_t* mix = (bf16_t*)(a.ws + WS_HBUF);
    constexpr int NB = 8;
    for (int it0 = gw * NB; it0 < NTOK * 4; it0 += NGW * NB) { u32x2 ow[NB], gw2[NB];
#pragma unroll
        for (int k = 0; k < NB; ++k) { const int it = it0 + k, tok = it >> 2, c = (it & 3) * 256 + 4 * lane;
            ow[k] = __builtin_nontemporal_load((const u32x2*)(oraw + (size_t)tok * 1024 + c)); gw2[k] = __builtin_nontemporal_load((const u32x2*)(proj + (size_t)tok * NPROJ + PJ_GR + c)); }
#pragma unroll
        for (int k = 0; k < NB; ++k) { const int it = it0 + k, tok = it >> 2, c = (it & 3) * 256 + 4 * lane; const f32x4 g4 = *(const f32x4*)(a.gla_og + c);
            const float o0 = bf_lo(ow[k].x), o1 = bf_hi(ow[k].x), o2 = bf_lo(ow[k].y), o3 = bf_hi(ow[k].y);
            const float rs = rsqrtf(wave_sum(o0 * o0 + o1 * o1 + o2 * o2 + o3 * o3) * (1.f / 256.f) + EPS);
            const float g0 = bf_lo(gw2[k].x), g1 = bf_hi(gw2[k].x), g2 = bf_lo(gw2[k].y), g3 = bf_hi(gw2[k].y);
            *(unsigned*)((unsigned char*)mix + (size_t)tok * DM + 1024 + c) = pk4_fp8(o0 * rs * g4[0] * (g0 * __builtin_amdgcn_rcpf(1.f + __expf(-g0))), o1 * rs * g4[1] * (g1 * __builtin_amdgcn_rcpf(1.f + __expf(-g1))),
                                                                                       o2 * rs * g4[2] * (g2 * __builtin_amdgcn_rcpf(1.f + __expf(-g2))), o3 * rs * g4[3] * (g3 * __builtin_amdgcn_rcpf(1.f + __expf(-g3))), FP8_SA); } }
}
}

namespace att {
constexpr int KT = 128;
constexpr int KROW = 208, SHM_K = KT * KROW, VTROW = KT + 16, SHM_V = 128 * VTROW;
constexpr int L_V = 0, L_K = 2 * SHM_V, L_WS = L_K + 2 * SHM_K;
#define SBAR() __builtin_amdgcn_sched_barrier(0)
__device__ __forceinline__ int v_st(int k, int c) { const int kk = (k & ~0xC) | ((k & 4) << 1) | ((k & 8) >> 1); return ((kk >> 3) * 4 + (c >> 5)) * 512 + ((kk & 7) * 32 + (c & 31)) * 2; }
__device__ __forceinline__ int v_rd_base(int lane) { return ((lane & 3) << 3) | (((lane >> 2) & 3) << 6) | (((lane >> 4) & 1) << 5) | (((lane >> 5) & 1) << 8); }
constexpr int v_rd_off(int d0, int ks, int half) { return d0 * 512 + ks * 4096 + half * 2048; }
__device__ __forceinline__ int crow(int r, int hi) { return (r & 3) + 8 * (r >> 2) + 4 * hi; }

__device__ __forceinline__ void pv_tile(f32x16* o, int vb, bf16x8 pa0, bf16x8 pa1, bf16x8 pa2, bf16x8 pa3) {
#define TRRD(dst, off) asm volatile("ds_read_b64_tr_b16 %0, %1 offset:%2" : "=&v"(dst) : "v"(vb), "i"(off) : "memory")
#define PV_D0(d0) do { s16x4 l0, l1, l2, l3, h0, h1, h2, h3; constexpr int b_ = v_rd_off(d0, 0, 0); \
        TRRD(l0, b_); TRRD(h0, b_ + 2048); TRRD(l1, b_ + 4096); TRRD(h1, b_ + 6144); TRRD(l2, b_ + 8192); TRRD(h2, b_ + 10240); TRRD(l3, b_ + 12288); TRRD(h3, b_ + 14336); \
        asm volatile("s_waitcnt lgkmcnt(0)" ::: "memory"); SBAR(); \
        o[d0] = __builtin_amdgcn_mfma_f32_32x32x16_bf16(pa0, (bf16x8){l0[0], l0[1], l0[2], l0[3], h0[0], h0[1], h0[2], h0[3]}, o[d0], 0, 0, 0); \
        o[d0] = __builtin_amdgcn_mfma_f32_32x32x16_bf16(pa1, (bf16x8){l1[0], l1[1], l1[2], l1[3], h1[0], h1[1], h1[2], h1[3]}, o[d0], 0, 0, 0); \
        o[d0] = __builtin_amdgcn_mfma_f32_32x32x16_bf16(pa2, (bf16x8){l2[0], l2[1], l2[2], l2[3], h2[0], h2[1], h2[2], h2[3]}, o[d0], 0, 0, 0); \
        o[d0] = __builtin_amdgcn_mfma_f32_32x32x16_bf16(pa3, (bf16x8){l3[0], l3[1], l3[2], l3[3], h3[0], h3[1], h3[2], h3[3]}, o[d0], 0, 0, 0); } while (0)
    PV_D0(0); PV_D0(1); PV_D0(2); PV_D0(3);
#undef PV_D0
#undef TRRD
}

__device__ __forceinline__ void attn_block(const int wave_s, const Args& a, char* lds, int b, int h, int qb) {
    int tid; asm volatile("v_mbcnt_lo_u32_b32 %0, -1, 0\n\tv_mbcnt_hi_u32_b32 %0, -1, %0" : "=v"(tid)); tid |= wave_s << 6;
    float l_reg = 0.f; f32x16 o[4] = {};
    const int tok0 = b * SEQ;
    bf16_t* mix = (bf16_t*)(a.ws + WS_HBUF);
    {
    const int wid = __builtin_amdgcn_readfirstlane(tid >> 6), lane = tid & 63, r32 = lane & 31, hi = lane >> 5;
    const unsigned char* Q8 = a.ws + WS_QMLA; const unsigned char* K8 = a.ws + WS_K8; const unsigned char* VT8 = a.ws + WS_VT8; const unsigned char* PE8 = a.ws + WS_KPE;
    const int q0 = qb * 256, NT = (q0 + 256) / KT, qlo = q0 + wid * 32, qm = qlo + r32 - 4 * hi;
    char* V_lds = lds + L_V; char* K_lds = lds + L_K;
    i32x8v qf[3];
    { const unsigned char* qp = Q8 + (size_t)(tok0 + qlo + r32) * 1536 + h * 192 + 32 * hi;
#pragma unroll
      for (int st = 0; st < 3; ++st) { const i32x4v lo_ = *(const i32x4v*)(qp + 64 * st), hi_ = *(const i32x4v*)(qp + 64 * st + 16); qf[st] = __builtin_shufflevector(lo_, hi_, 0, 1, 2, 3, 4, 5, 6, 7); } }
#pragma unroll
    for (int st = 0; st < 3; ++st) asm volatile("" : "+v"(qf[st]));
    const int kkey = tid >> 3, kpart = tid & 7, rkey = tid >> 2, rpart = tid & 3, vcol = tid >> 3, vpart = tid & 7;
    const int kdst = kkey * KROW + 16 * kpart, rdst = rkey * KROW + 128 + 16 * rpart, vdst = vcol * VTROW + 16 * vpart;
    const unsigned kofs = (unsigned)(kkey * 1024 + 16 * kpart), pofs = (unsigned)(rkey * 64 + 16 * rpart), vofs = (unsigned)(vcol * NTOK + 16 * vpart);
    i32x4v sk[2], sr, sv[2];
#define SLOAD(kb) do { const unsigned char* kb_ = K8 + (size_t)(tok0 + (kb)) * 1024 + h * 128; const unsigned char* pb_ = PE8 + (size_t)(tok0 + (kb)) * 64; const unsigned char* vb_ = VT8 + (size_t)(h * 128) * NTOK + tok0 + (kb); \
        sk[0] = *(const i32x4v*)(kb_ + kofs); sk[1] = *(const i32x4v*)(kb_ + kofs + 64 * 1024); sr = *(const i32x4v*)(pb_ + pofs); sv[0] = *(const i32x4v*)(vb_ + vofs); sv[1] = *(const i32x4v*)(vb_ + vofs + 64 * NTOK); } while (0)
#define SWRITE(bf) do { *(i32x4v*)(K_lds + (bf) * SHM_K + kdst) = sk[0]; *(i32x4v*)(K_lds + (bf) * SHM_K + kdst + 64 * KROW) = sk[1]; *(i32x4v*)(K_lds + (bf) * SHM_K + rdst) = sr; \
        *(i32x4v*)(V_lds + (bf) * SHM_V + vdst) = sv[0]; *(i32x4v*)(V_lds + (bf) * SHM_V + vdst + 64 * VTROW) = sv[1]; } while (0)
    float m_reg = -1e30f;
    constexpr float SCI = 1.f / (FP8_SQ * FP8_SK);
#define LD32(P_) ({ const i32x4v lo_ = *(const i32x4v*)(P_), hi_ = *(const i32x4v*)((P_) + 16); __builtin_shufflevector(lo_, hi_, 0, 1, 2, 3, 4, 5, 6, 7); })
#define MFMA8(ACC, A_, B_) asm volatile("v_mfma_f32_32x32x64_f8f6f4 %0, %1, %2, %0" : "+v"(ACC) : "v"(A_), "v"(B_))
#define PK4F(P, B_) ({ int p_ = __builtin_amdgcn_cvt_pk_fp8_f32(P[(B_) + 0], P[(B_) + 1], 0, false); p_ = __builtin_amdgcn_cvt_pk_fp8_f32(P[(B_) + 2], P[(B_) + 3], p_, true); (unsigned)p_; })
    SLOAD(0); SWRITE(0);
    __syncthreads();
#pragma unroll 1
    for (int t = 0; t < NT; ++t) { const int bf = t & 1, kb = t * KT;
        SLOAD((t + 1 < NT ? kb + KT : kb));
        if (kb <= qlo + 31) {
        const bool two = kb + 64 <= qlo + 31;
        f32x16 p0 = {}, p1 = {}, p2 = {}, p3 = {};
        { const char* kp = K_lds + bf * SHM_K + r32 * KROW + 32 * hi; __builtin_amdgcn_s_setprio(1);
#pragma unroll
          for (int st = 0; st < 3; ++st) { const i32x8v k0 = LD32(kp + 64 * st), k1 = LD32(kp + 64 * st + 32 * KROW); MFMA8(p0, k0, qf[st]); MFMA8(p1, k1, qf[st]); }
          if (two) {
#pragma unroll
            for (int st = 0; st < 3; ++st) { const i32x8v k2 = LD32(kp + 64 * st + 64 * KROW), k3 = LD32(kp + 64 * st + 96 * KROW); MFMA8(p2, k2, qf[st]); MFMA8(p3, k3, qf[st]); } }
          __builtin_amdgcn_s_setprio(0); asm volatile("s_nop 15\n\ts_nop 7" ::: "memory"); }
        const float NEG = -__builtin_inff();
        if (!two) {
#pragma unroll
            for (int r = 0; r < 16; ++r) { p2[r] = NEG; p3[r] = NEG; } }
        if (kb + KT - 1 > qlo) { const int dq = qm - kb;
#pragma unroll
            for (int r = 0; r < 16; ++r) { const int c = (r & 3) + 8 * (r >> 2); if (dq - c < 0) p0[r] = NEG; if (dq - c - 32 < 0) p1[r] = NEG; if (dq - c - 64 < 0) p2[r] = NEG; if (dq - c - 96 < 0) p3[r] = NEG; } }
        float pmax = p0[0];
#pragma unroll
        for (int r = 1; r < 16; ++r) pmax = fmaxf(pmax, p0[r]);
#pragma unroll
        for (int r = 0; r < 16; ++r) pmax = fmaxf(fmaxf(pmax, p1[r]), fmaxf(p2[r], p3[r]));
        { auto rr = __builtin_amdgcn_permlane32_swap(__float_as_uint(pmax), __float_as_uint(pmax), false, false); pmax = fmaxf(__uint_as_float(rr[0]), __uint_as_float(rr[1])); }
        pmax *= SCI;
        float mn = m_reg, alpha = 1.f;
        if (!__all(pmax - m_reg <= 8.f)) { mn = fmaxf(m_reg, pmax); alpha = __builtin_amdgcn_exp2f(m_reg - mn); m_reg = mn; }
        float ps = 0.f;
#pragma unroll
        for (int r = 0; r < 16; ++r) { p0[r] = __builtin_amdgcn_exp2f(__builtin_fmaf(p0[r], SCI, -mn)); p1[r] = __builtin_amdgcn_exp2f(__builtin_fmaf(p1[r], SCI, -mn));
            p2[r] = __builtin_amdgcn_exp2f(__builtin_fmaf(p2[r], SCI, -mn)); p3[r] = __builtin_amdgcn_exp2f(__builtin_fmaf(p3[r], SCI, -mn)); ps += (p0[r] + p1[r]) + (p2[r] + p3[r]); }
        { auto rr = __builtin_amdgcn_permlane32_swap(__float_as_uint(ps), __float_as_uint(ps), false, false); ps = __uint_as_float(rr[0]) + __uint_as_float(rr[1]); }
        l_reg = l_reg * alpha + ps;
        if (__any(alpha < 1.f)) { int r32o = r32, hio = hi; asm volatile("" : "+v"(r32o), "+v"(hio)); float* al_l = (float*)(lds + L_WS) + wid * 64 + 32; if (hio == 0) al_l[r32o] = alpha; asm volatile("s_waitcnt lgkmcnt(0)" ::: "memory"); __builtin_amdgcn_wave_barrier();
#pragma unroll
            for (int r = 0; r < 16; ++r) { const float f = al_l[crow(r, hio)];
#pragma unroll
                for (int d_ = 0; d_ < 4; ++d_) o[d_][r] *= f; } }
        i32x8v pa, pb;
#pragma unroll
        for (int i = 0; i < 4; ++i) { auto rr = __builtin_amdgcn_permlane32_swap(PK4F(p0, 4 * i), PK4F(p1, 4 * i), false, false); pa[2 * i] = (int)rr[0]; pa[2 * i + 1] = (int)rr[1]; }
#pragma unroll
        for (int i = 0; i < 4; ++i) { auto rr = __builtin_amdgcn_permlane32_swap(PK4F(p2, 4 * i), PK4F(p3, 4 * i), false, false); pb[2 * i] = (int)rr[0]; pb[2 * i + 1] = (int)rr[1]; }
        { const char* vp = V_lds + bf * SHM_V + r32 * VTROW + 32 * hi; __builtin_amdgcn_s_setprio(1);
#pragma unroll
          for (int d0 = 0; d0 < 4; ++d0) { const i32x8v vf = LD32(vp + d0 * 32 * VTROW); MFMA8(o[d0], pa, vf); }
          if (two) {
#pragma unroll
            for (int d0 = 0; d0 < 4; ++d0) { const i32x8v vf = LD32(vp + d0 * 32 * VTROW + 64); MFMA8(o[d0], pb, vf); } }
          __builtin_amdgcn_s_setprio(0); } }
        if (t + 1 < NT) SWRITE(bf ^ 1);
        __syncthreads(); }
    asm volatile("s_nop 15\n\ts_nop 7" ::: "memory");
#undef LD32
#undef MFMA8
#undef PK4F
#undef SLOAD
#undef SWRITE
    }
    int tid3; asm volatile("v_mbcnt_lo_u32_b32 %0, -1, 0\n\tv_mbcnt_hi_u32_b32 %0, -1, %0" : "=v"(tid3)); tid3 |= wave_s << 6;
    const int wid3 = __builtin_amdgcn_readfirstlane(tid3 >> 6), r32 = tid3 & 31, hi = (tid3 >> 5) & 1, qlo = qb * 256 + wid3 * 32;
    float* li_l = (float*)(lds + L_WS) + wid3 * 64;
    if (hi == 0) li_l[r32] = l_reg; asm volatile("s_waitcnt lgkmcnt(0)" ::: "memory"); __builtin_amdgcn_wave_barrier();
    float g4[4];
#pragma unroll
    for (int d0 = 0; d0 < 4; ++d0) g4[d0] = a.mla_og[h * 128 + d0 * 32 + r32];
#pragma unroll
    for (int r = 0; r < 16; ++r) { const float rl = __builtin_amdgcn_rcpf(li_l[crow(r, hi)]); float ss = 0.f;
#pragma unroll
        for (int d0 = 0; d0 < 4; ++d0) { o[d0][r] *= rl * (1.f / FP8_SK); ss += o[d0][r] * o[d0][r]; }
        ss += __shfl_xor(ss, 1); ss += __shfl_xor(ss, 2); ss += __shfl_xor(ss, 4); ss += __shfl_xor(ss, 8); ss += __shfl_xor(ss, 16);
        const float rs = rsqrtf(ss * (1.f / 128.f) + EPS);
        unsigned char* orow = (unsigned char*)mix + (size_t)(tok0 + qlo + crow(r, hi)) * DM + h * 128;
        *(unsigned*)(orow + 4 * r32) = pk4_fp8(o[0][r] * rs * g4[0], o[1][r] * rs * g4[1], o[2][r] * rs * g4[2], o[3][r] * rs * g4[3], FP8_SA); }
    __syncthreads();
}
#undef SBAR
}

namespace peer {
__device__ __forceinline__ f32x2 fp8lo(unsigned w) { return __builtin_amdgcn_cvt_pk_f32_fp8((int)w, false); }
__device__ __forceinline__ f32x2 fp8hi(unsigned w) { return __builtin_amdgcn_cvt_pk_f32_fp8((int)w, true); }
struct UIds { u32x4 e[2]; u32x4 h0, h1; };
#define XID16(E, i) ((E[(i) >> 3][((i) >> 1) & 3] >> (16 * ((i) & 1))) & 0xffffu)
constexpr int PEER_CH = 32, PEER_NCH = NTOK / PEER_CH;
#ifndef PEER_AUX
#define PEER_AUX 0
#endif
struct TokGen { unsigned* qh; int c, p, lane; unsigned cnv;
    __device__ __forceinline__ unsigned grabv() { unsigned v = 0u; if (lane == 0) v = __builtin_amdgcn_atomic_inc32(qh, 0xffffffffu, __ATOMIC_RELAXED, "agent"); return v; }
    __device__ __forceinline__ void init(unsigned* q, int ln) { qh = q; lane = ln; p = 0; c = (int)__builtin_amdgcn_readfirstlane(grabv()); cnv = grabv(); }
    __device__ __forceinline__ int next() { if (p == PEER_CH) { p = 0; c = (int)__builtin_amdgcn_readfirstlane(cnv); cnv = grabv(); }
        if (c >= PEER_NCH) { p = 0; return -1; } const int t = c * PEER_CH + p; ++p; return t; }
};
__device__ __forceinline__ void phase_u(const int tid, const Args& a) {
    const int lane = tid & 63, g8 = lane >> 3, l8 = lane & 7;
    const int grp = blockIdx.x & 7;
    const bf16_t* h2 = (const bf16_t*)(a.ws + WS_Y); const unsigned short* exp16 = (const unsigned short*)(a.ws + WS_EXP16); bf16_t* part = (bf16_t*)(a.ws + WS_PART);
#define U_LOAD_IDS(I, t_) do { const int t = (t_); \
        _Pragma("unroll") for (int c = 0; c < 2; ++c) I.e[c] = *(const u32x4*)(exp16 + (size_t)t * 128 + 16 * g8 + 8 * c); \
        I.h0 = __builtin_nontemporal_load((const u32x4*)(h2 + (size_t)t * DM + sl * 128 + 16 * l8)); I.h1 = __builtin_nontemporal_load((const u32x4*)(h2 + (size_t)t * DM + sl * 128 + 16 * l8 + 8)); } while (0)
#define U_LOAD_TAB(W, I) do { _Pragma("unroll") for (int i = 0; i < 16; ++i) W[i] = __builtin_amdgcn_raw_buffer_load_b128(trs, XID16(I.e, i) * 128u + lofs, 0, PEER_AUX); } while (0)
#define PU_LEVEL(NH, ST, BIT, XF) _Pragma("unroll") for (int j = 0; j < (NH); ++j) { const bool up = (lane >> (BIT)) & 1; const float keep = up ? p[j + (ST)] : p[j], send = up ? p[j] : p[j + (ST)]; p[j] = keep + XF(send); }
#define U_COMPUTE(W, I, t_) do { f32x2 h[8]; \
        _Pragma("unroll") for (int k = 0; k < 4; ++k) { h[k] = (f32x2){bf_lo(I.h0[k]), bf_hi(I.h0[k])}; h[4 + k] = (f32x2){bf_lo(I.h1[k]), bf_hi(I.h1[k])}; } \
        float p[16]; \
        _Pragma("unroll") for (int i = 0; i < 16; ++i) { f32x2 d = fp8lo(W[i][0]) * h[0] + fp8hi(W[i][0]) * h[1]; \
            d += fp8lo(W[i][1]) * h[2] + fp8hi(W[i][1]) * h[3]; d += fp8lo(W[i][2]) * h[4] + fp8hi(W[i][2]) * h[5]; d += fp8lo(W[i][3]) * h[6] + fp8hi(W[i][3]) * h[7]; p[i] = d[0] + d[1]; } \
        PU_LEVEL(8, 8, 2, lx7) PU_LEVEL(4, 4, 1, lx2) PU_LEVEL(2, 2, 0, lx1) \
        bf16_t* pp = part + ((size_t)sl * NTOK + (t_)) * 128 + 16 * g8 + 2 * l8; *(unsigned*)pp = cvt_pk_bf16(p[0], p[1]); } while (0)
    for (int sp = 0; sp < 2; ++sp) { const int sl = 2 * grp + sp; const unsigned char* T = a.ws + WS_UTAB + (size_t)sl * 16384 * 128; const unsigned lofs = 16u * (unsigned)l8; const __amdgpu_buffer_rsrc_t trs = __builtin_amdgcn_make_buffer_rsrc((void*)T, (short)0, 16384 * 128, 0x00020000);
        TokGen tg; tg.init((unsigned*)(a.ws + WS_CTL + CTL_QUEUE) + 64 * (16 + sl), lane);
        int t0 = tg.next(); if (t0 < 0) continue;
        int t1 = tg.next();
        UIds IA, IB, IC, ID; u32x4 WA[16], WB[16];
        U_LOAD_IDS(IA, t0); U_LOAD_IDS(IB, t1 >= 0 ? t1 : t0);
        U_LOAD_TAB(WA, IA);
#pragma unroll 1
        for (;;) { const int t2 = t1 >= 0 ? tg.next() : -1, t3 = t2 >= 0 ? tg.next() : -1;
            U_LOAD_IDS(IC, t2 >= 0 ? t2 : t0);
            U_LOAD_TAB(WB, IB);
            U_COMPUTE(WA, IA, t0);
            U_LOAD_IDS(ID, t3 >= 0 ? t3 : t0);
            U_LOAD_TAB(WA, IC);
            if (t1 >= 0) U_COMPUTE(WB, IB, t1);
            if (t2 < 0) break;
            IA = IC; IB = ID; t0 = t2; t1 = t3; } }
#undef PU_LEVEL
#undef U_COMPUTE
#undef U_LOAD_TAB
#undef U_LOAD_IDS
}
__device__ __forceinline__ float erf_as(float x) {
    const float ax = fabsf(x), t = __builtin_amdgcn_rcpf(1.f + 0.3275911f * ax);
    const float poly = t * (0.254829592f + t * (-0.284496736f + t * (1.421413741f + t * (-1.453152027f + t * 1.061405429f))));
    const float r = 1.f - poly * __expf(-ax * ax); return x < 0.f ? -r : r; }
__device__ __forceinline__ void phase_w(const int tid, const Args& a) {
    const bf16_t* part = (const bf16_t*)(a.ws + WS_PART); const int* experts = (const int*)(a.ws + WS_EXPERTS); const float* gates = (const float*)(a.ws + WS_GATES); bf16_t* wts = (bf16_t*)(a.ws + WS_WTS);
    const float* usc = (const float*)(a.ws + WS_USC); const float* vsc = (const float*)(a.ws + WS_VSC); const float* ush = (const float*)(a.ws + WS_USH); const u64* ssx1 = (const u64*)(a.ws + WS_CTL + CTL_SSX1);
    for (int i8 = blockIdx.x * NTHREADS + tid; i8 < NTOK * 16; i8 += gridDim.x * NTHREADS) { const size_t i = 8 * (size_t)i8; float d[8] = {0.f, 0.f, 0.f, 0.f, 0.f, 0.f, 0.f, 0.f};
        const u32x4 e0 = *(const u32x4*)(experts + i), e1 = *(const u32x4*)(experts + i + 4);
        u32x4 pw[16];
#pragma unroll
        for (int sl = 0; sl < 16; ++sl) pw[sl] = __builtin_nontemporal_load((const u32x4*)(part + (size_t)sl * NTOK * 128 + i));
        const f32x4 g0 = *(const f32x4*)(gates + i), g1 = *(const f32x4*)(gates + i + 4);
        const int t = i8 >> 4; const float rstd = rsqrtf(ss_get(ssx1 + t) * (1.f / DM) + EPS); const f32x4* sc4 = (const f32x4*)(a.ws + WS_SC4) + (size_t)(t >> 12) * 16384;
        const unsigned ex[8] = {e0.x, e0.y, e0.z, e0.w, e1.x, e1.y, e1.z, e1.w}; const float g[8] = {g0[0], g0[1], g0[2], g0[3], g1[0], g1[1], g1[2], g1[3]};
        float uc[8], vc[8], hc[8];
#pragma unroll
        for (int k = 0; k < 8; ++k) { const f32x4 e4 = sc4[ex[k]]; uc[k] = e4[0]; vc[k] = e4[1]; hc[k] = e4[2]; }
#pragma unroll
        for (int sl = 0; sl < 16; ++sl) { d[0] += bf_lo(pw[sl].x); d[1] += bf_hi(pw[sl].x); d[2] += bf_lo(pw[sl].y); d[3] += bf_hi(pw[sl].y); d[4] += bf_lo(pw[sl].z); d[5] += bf_hi(pw[sl].z); d[6] += bf_lo(pw[sl].w); d[7] += bf_hi(pw[sl].w); }
        float o[8];
#pragma unroll
        for (int k = 0; k < 8; ++k) { const float dd = d[k] * (uc[k] * rstd) + hc[k]; o[k] = g[k] * vc[k] * 0.5f * dd * (1.f + erf_as(dd * 0.7071067811865476f)); }
        *(u32x4*)(wts + i) = (u32x4){cvt_pk_bf16(o[0], o[1]), cvt_pk_bf16(o[2], o[3]), cvt_pk_bf16(o[4], o[5]), cvt_pk_bf16(o[6], o[7])}; }
}
struct VIds { u32x4 e[2]; u32x4 w[2]; };
__device__ __forceinline__ void phase_v(const int tid, const Args& a) {
    const int lane = tid & 63, g8 = lane >> 3, l8 = lane & 7;
    const int grp = blockIdx.x & 7;
    const unsigned short* exp16 = (const unsigned short*)(a.ws + WS_EXP16); const bf16_t* wts = (const bf16_t*)(a.ws + WS_WTS); bf16_t* contrib = (bf16_t*)(a.ws + WS_PART);
    const int cl = 16 * l8 + 8 * ((lane >> 5) & 1) + 4 * ((lane >> 4) & 1) + 2 * ((lane >> 3) & 1);
#define V_LOAD_IDS(I, t_) do { const int t = (t_); \
        _Pragma("unroll") for (int c = 0; c < 2; ++c) { I.e[c] = *(const u32x4*)(exp16 + (size_t)t * 128 + 16 * g8 + 8 * c); I.w[c] = *(const u32x4*)(wts + (size_t)t * 128 + 16 * g8 + 8 * c); } } while (0)
#define V_LOAD_TAB(W, I) do { _Pragma("unroll") for (int i = 0; i < 16; ++i) W[i] = __builtin_amdgcn_raw_buffer_load_b128(trs, XID16(I.e, i) * 128u + lofs, 0, PEER_AUX); } while (0)
#define PV_LEVEL(NH, ST, BIT, XF) _Pragma("unroll") for (int j = 0; j < (NH); ++j) { const bool up = (lane >> (BIT)) & 1; const float keep = up ? p[j + (ST)] : p[j], send = up ? p[j] : p[j + (ST)]; p[j] = keep + XF; }
#define V_COMPUTE(W, I, t_) do { f32x2 ac[8]; \
        _Pragma("unroll") for (int k = 0; k < 8; ++k) ac[k] = (f32x2){0.f, 0.f}; \
        _Pragma("unroll") for (int i = 0; i < 16; ++i) { const unsigned wp_ = I.w[i >> 3][(i >> 1) & 3]; const float wv = (i & 1) ? bf_hi(wp_) : bf_lo(wp_); const f32x2 w2 = {wv, wv}; \
            _Pragma("unroll") for (int k = 0; k < 4; ++k) { ac[2 * k] += w2 * fp8lo(W[i][k]); ac[2 * k + 1] += w2 * fp8hi(W[i][k]); } } \
        float p[16]; \
        _Pragma("unroll") for (int k = 0; k < 8; ++k) { p[2 * k] = ac[k][0]; p[2 * k + 1] = ac[k][1]; } \
        PV_LEVEL(8, 8, 5, lx32(send, lane)) PV_LEVEL(4, 4, 4, lx16(send, lane)) PV_LEVEL(2, 2, 3, lx8(send)) \
        *(unsigned*)(contrib + (size_t)(t_) * DM + sl * 128 + cl) = cvt_pk_bf16(p[0], p[1]); } while (0)
    for (int sp = 0; sp < 2; ++sp) { const int sl = 2 * grp + sp; const unsigned char* T = a.ws + WS_VTAB + (size_t)sl * 16384 * 128; const unsigned lofs = 16u * (unsigned)l8; const __amdgpu_buffer_rsrc_t trs = __builtin_amdgcn_make_buffer_rsrc((void*)T, (short)0, 16384 * 128, 0x00020000);
        TokGen tg; tg.init((unsigned*)(a.ws + WS_CTL + CTL_QUEUE) + 64 * (32 + sl), lane);
        int t0 = tg.next(); if (t0 < 0) continue;
        int t1 = tg.next();
        VIds IA, IB, IC, ID; u32x4 WA[16], WB[16];
        V_LOAD_IDS(IA, t0); V_LOAD_IDS(IB, t1 >= 0 ? t1 : t0);
        V_LOAD_TAB(WA, IA);
#pragma unroll 1
        for (;;) { const int t2 = t1 >= 0 ? tg.next() : -1, t3 = t2 >= 0 ? tg.next() : -1;
            V_LOAD_IDS(IC, t2 >= 0 ? t2 : t0);
            V_LOAD_TAB(WB, IB);
            V_COMPUTE(WA, IA, t0);
            V_LOAD_IDS(ID, t3 >= 0 ? t3 : t0);
            V_LOAD_TAB(WA, IC);
            if (t1 >= 0) V_COMPUTE(WB, IB, t1);
            if (t2 < 0) break;
            IA = IC; IB = ID; t0 = t2; t1 = t3; } }
#undef PV_LEVEL
#undef V_COMPUTE
#undef V_LOAD_TAB
#undef V_LOAD_IDS
}
__device__ __forceinline__ void phase_final(const int tid, const Args& a) {
    const int lane = tid & 63, wave = __builtin_amdgcn_readfirstlane(tid >> 6), gw = blockIdx.x * NWAVES + wave, NGW = gridDim.x * NWAVES;
    const float* modz = (const float*)(a.ws + WS_CTL + CTL_MODZ); const bf16_t* contrib = (const bf16_t*)(a.ws + WS_PART); const bf16_t* x1b = (const bf16_t*)(a.ws + WS_X1);
    for (int grp = gw; grp < NTOK / 8; grp += NGW) { const int row0 = grp * 8, b = row0 >> 12;
        f32x4 g2[8], fg[8];
#pragma unroll
        for (int j = 0; j < 8; ++j) { const int col = 256 * j + 4 * lane; fg[j] = *(const f32x4*)(a.fin_g + col); g2[j] = *(const f32x4*)(modz + (size_t)b * NMOD + MOD_G2 + col) + *(const f32x4*)(a.ada_b + MOD_G2 + col); }
        u32x2 xn[8], cn[8];
#pragma unroll
        for (int j = 0; j < 8; ++j) { xn[j] = __builtin_nontemporal_load((const u32x2*)(x1b + (size_t)row0 * DM + 4 * lane + 256 * j)); cn[j] = __builtin_nontemporal_load((const u32x2*)(contrib + (size_t)row0 * DM + 4 * lane + 256 * j)); }
#pragma unroll 1
        for (int r = 0; r < 8; ++r) { const int row = row0 + r; float* xr = a.out + (size_t)row * DM + 4 * lane;
            f32x4 v[8]; float ss = 0.f; u32x2 xc[8], cc[8];
#pragma unroll
            for (int j = 0; j < 8; ++j) { xc[j] = xn[j]; cc[j] = cn[j]; }
            { const int rn = r + 1 < 8 ? row + 1 : row;
#pragma unroll
              for (int j = 0; j < 8; ++j) { xn[j] = __builtin_nontemporal_load((const u32x2*)(x1b + (size_t)rn * DM + 4 * lane + 256 * j)); cn[j] = __builtin_nontemporal_load((const u32x2*)(contrib + (size_t)rn * DM + 4 * lane + 256 * j)); } }
#pragma unroll
            for (int j = 0; j < 8; ++j) { const u32x2 xw = xc[j]; const u32x2 cw = cc[j];
                v[j][0] = bf_lo(xw.x) + g2[j][0] * bf_lo(cw.x); v[j][1] = bf_hi(xw.x) + g2[j][1] * bf_hi(cw.x); v[j][2] = bf_lo(xw.y) + g2[j][2] * bf_lo(cw.y); v[j][3] = bf_hi(xw.y) + g2[j][3] * bf_hi(cw.y);
                ss += v[j][0] * v[j][0] + v[j][1] * v[j][1] + v[j][2] * v[j][2] + v[j][3] * v[j][3]; }
            const float rstd = rsqrtf(wave_sum(ss) * (1.f / DM) + EPS);
#pragma unroll
            for (int j = 0; j < 8; ++j) __builtin_nontemporal_store(v[j] * rstd * fg[j], (f32x4*)(xr + 256 * j)); } }
}
}

#define XB_TMO      128
#define XB_XCNT(j)  (256  + 64 * (j))
#define XB_XSUB(j)  (1280 + 64 * (j))
#define XB_XGEN(j)  (2304 + 64 * (j))
#define XB_TOP      3328
#define XB_TOPGEN   3392
#define XCD_BAR_WORDS 3456
#define XB_SPIN_CAP (1u << 20)
__device__ __forceinline__ unsigned xb_ld(unsigned* p)              { return __hip_atomic_load(p, __ATOMIC_RELAXED, __HIP_MEMORY_SCOPE_AGENT); }
__device__ __forceinline__ unsigned xb_add(unsigned* p, unsigned v) { return __hip_atomic_fetch_add(p, v, __ATOMIC_RELAXED, __HIP_MEMORY_SCOPE_AGENT); }
__device__ __forceinline__ unsigned xb_xcc_id() { return (unsigned)__builtin_amdgcn_s_getreg((3 << 11) | 20) & 0xFu; }
#define XB_SPIN(cond, bar) do { unsigned _sp = 0; while (cond) { __builtin_amdgcn_s_sleep(1); \
    if ((++_sp & 255u) == 0u) { if (xb_ld(&(bar)[XB_TMO])) break; if (_sp > XB_SPIN_CAP) { atomicAdd(&(bar)[XB_TMO], 1u); break; } } } } while (0)
__device__ __forceinline__ void xcd_barrier_complete(unsigned* bar, unsigned x, unsigned& nloc, unsigned& nx) {
    const unsigned G = gridDim.x;
    unsigned sum, cnt, mine, sp = 0u;
    for (;;) {
        sum = 0u; cnt = 0u; mine = 0u;
#pragma unroll
        for (unsigned j = 0; j < 16; ++j) { const unsigned c = xb_ld(&bar[XB_XCNT(j)]); sum += c; cnt += (c > 0u) ? 1u : 0u; mine = (j == x) ? c : mine; }
        if (sum == G) break;
        __builtin_amdgcn_s_sleep(1);
        if ((++sp & 255u) == 0u) { if (xb_ld(&bar[XB_TMO])) break; if (sp > XB_SPIN_CAP) { atomicAdd(&bar[XB_TMO], 1u); break; } }
    }
    nloc = mine > 0u ? mine : 1u; nx = cnt > 0u ? cnt : 1u;
}
__device__ __forceinline__ void xcd_barrier(const int tid, unsigned* bar, volatile unsigned* st) {
    asm volatile("s_waitcnt vmcnt(0)" ::: "memory");
    __syncthreads();
    if (tid == 0) {
        __builtin_amdgcn_s_waitcnt(0);
        const unsigned x = xb_xcc_id();
        unsigned nloc = st[0], nx = st[1];
        if (nloc == 0u) { xcd_barrier_complete(bar, x, nloc, nx); st[0] = nloc; st[1] = nx; }
        const unsigned old = xb_add(&bar[XB_XSUB(x)], 1u);
        const unsigned gen = old / nloc;
        if (old + 1u == (gen + 1u) * nloc) {
            __builtin_amdgcn_fence(__ATOMIC_RELEASE, "agent");
            asm volatile("s_waitcnt vmcnt(0)" ::: "memory");
            const unsigned og = xb_add(&bar[XB_TOP], 1u);
            const unsigned tg = og / nx;
            if (og + 1u == (tg + 1u) * nx) xb_add(&bar[XB_TOPGEN], 1u);
            else XB_SPIN(xb_ld(&bar[XB_TOPGEN]) == tg, bar);
            __builtin_amdgcn_fence(__ATOMIC_ACQUIRE, "agent");
            xb_add(&bar[XB_XGEN(x)], 1u);
            asm volatile("s_waitcnt vmcnt(0)" ::: "memory");
        } else {
            XB_SPIN(xb_ld(&bar[XB_XGEN(x)]) == gen, bar);
            __builtin_amdgcn_fence(__ATOMIC_ACQUIRE, "agent");
            asm volatile("s_waitcnt vmcnt(0)" ::: "memory");
        }
    }
    __syncthreads();
}

#ifndef EN_MLA
#define EN_MLA 1
#endif
#ifndef EN_GLA
#define EN_GLA 1
#endif
#ifndef EN_PEER
#define EN_PEER 1
#endif
constexpr int NPHASE = 14;
#ifndef REPEAT_PHASE
#define REPEAT_PHASE -1
#endif
#define NREP(k) ((REPEAT_PHASE) == (k) ? 2 : 1)
#ifndef REPEAT_BAR
#define REPEAT_BAR 0
#endif
constexpr int MISC_OFF = LDS_BYTES - 64;

__global__ void __launch_bounds__(NTHREADS, 2) mega(Args ka) {
    extern __shared__ __attribute__((aligned(16))) unsigned char lds_raw[];
    char* lds = (char*)lds_raw; LAS unsigned char* lds3 = (LAS unsigned char*)lds_raw;
    const int lo = ka.ph_lo, hi = ka.ph_hi;
    const int wave_s = __builtin_amdgcn_readfirstlane((int)threadIdx.x >> 6);
#define FRESH_TID() ({ int l_; asm volatile("v_mbcnt_lo_u32_b32 %0, -1, 0\n\tv_mbcnt_hi_u32_b32 %0, -1, %0" : "=v"(l_)); (wave_s << 6) | l_; })
#define IN(k) (lo <= (k) && (k) < hi)
#define PHASE_VARS const int tid = FRESH_TID(); const Args a = fresh_args(); unsigned char* ws = a.ws; const int G = gridDim.x, bx = blockIdx.x; (void)G; (void)bx; (void)tid; \
    u64* ssq = (u64*)(ws + WS_CTL + CTL_SSQ); u64* sskv = (u64*)(ws + WS_CTL + CTL_SSKV); u64* ssx1 = (u64*)(ws + WS_CTL + CTL_SSX1); \
    const float* modz = (const float*)(ws + WS_CTL + CTL_MODZ); bf16_t* hbuf = (bf16_t*)(ws + WS_HBUF); bf16_t* proj = (bf16_t*)(ws + WS_PROJ); \
    (void)ssq; (void)sskv; (void)ssx1; (void)modz; (void)hbuf; (void)proj;
#ifndef PROBE_NBAR
#define PROBE_NBAR 1
#endif
#define SEAM(k) do { if (IN(k) && IN((k) + 1)) { for (int nb_ = 0; nb_ < PROBE_NBAR; ++nb_) { const int tid_ = FRESH_TID(); const Args a_ = fresh_args(); \
        xcd_barrier(tid_, (unsigned*)(a_.ws + WS_CTL + CTL_BAR), (volatile unsigned*)(lds + MISC_OFF)); } } } while (0)
    { const int tid = FRESH_TID(); if (tid < 2) ((volatile unsigned*)(lds + MISC_OFF))[tid] = 0u; __syncthreads();
      if (hi - lo > 1 && tid == 0) { const Args a_ = fresh_args(); (void)xb_add(&((unsigned*)(a_.ws + WS_CTL + CTL_BAR))[XB_XCNT(xb_xcc_id())], 1u); } }

    if (IN(0)) for (int rp = 0; rp < NREP(0); ++rp) { if (REPEAT_BAR && rp > 0) { const int tid_ = FRESH_TID(); const Args a_ = fresh_args(); xcd_barrier(tid_, (unsigned*)(a_.ws + WS_CTL + CTL_BAR), (volatile unsigned*)(lds + MISC_OFF)); } PHASE_VARS phase_p0(tid, a, lds, rp == 0); }
    SEAM(0);
    if (IN(1)) for (int rp = 0; rp < NREP(1); ++rp) { if (REPEAT_BAR && rp > 0) { const int tid_ = FRESH_TID(); const Args a_ = fresh_args(); xcd_barrier(tid_, (unsigned*)(a_.ws + WS_CTL + CTL_BAR), (volatile unsigned*)(lds + MISC_OFF)); } PHASE_VARS phase_rows<false>(tid, a); }
    SEAM(1);
    if (IN(2)) for (int rp = 0; rp < NREP(2); ++rp) { if (REPEAT_BAR && rp > 0) { const int tid_ = FRESH_TID(); const Args a_ = fresh_args(); xcd_barrier(tid_, (unsigned*)(a_.ws + WS_CTL + CTL_BAR), (volatile unsigned*)(lds + MISC_OFF)); } PHASE_VARS pg8::Gemm g{hbuf, (const bf16_t*)(ws + WS_BTIN), NTOK, NPROJ, DM / 2, DM / 2, DM / 2, 0}; pg8::StaticOrder S; S.init(NTOK, NPROJ, G, bx);
        pg8::EpiProj E{proj, NPROJ, ssq, sskv, rp == NREP(2) - 1, 1.f / (FP8_SA * FP8_SB)}; pg8::gemm_phase<true>(tid, lds3, g, S, E); }
    SEAM(2);
    if (IN(3)) for (int rp = 0; rp < NREP(3); ++rp) { if (REPEAT_BAR && rp > 0) { const int tid_ = FRESH_TID(); const Args a_ = fresh_args(); xcd_barrier(tid_, (unsigned*)(a_.ws + WS_CTL + CTL_BAR), (volatile unsigned*)(lds + MISC_OFF)); }
        { PHASE_VARS pg8::Gemm g{proj + PJ_CQ, (const bf16_t*)(ws + WS_BTUQ), NTOK, 1536, 512, NPROJ, 512, 0}; pg8::StaticOrder S; S.init(NTOK, 1536, G, bx);
          pg8::EpiQ E{ws + WS_QMLA, ssq, (const f32x2*)(ws + WS_CS)}; pg8::gemm_phase(tid, lds3, g, S, E); }
        { PHASE_VARS pg8::Gemm g{proj + PJ_CKV, (const bf16_t*)(ws + WS_BTK), NTOK, 1024, 256, NPROJ, 256, 0}; pg8::StaticOrder S; S.init(NTOK, 1024, G, bx);
          pg8::EpiK8 E{ws + WS_K8, sskv}; pg8::gemm_phase(tid, lds3, g, S, E); }
        { PHASE_VARS pg8::Gemm g{(const bf16_t*)(ws + WS_BTV), proj + PJ_CKV, 1024, NTOK, 256, 256, NPROJ, 0}; pg8::StaticOrder S; S.init(1024, NTOK, G, bx);
          pg8::EpiVT E{ws + WS_VT8, sskv}; pg8::gemm_phase(tid, lds3, g, S, E); }
        { PHASE_VARS phase_kpe(tid, a); }
        if (EN_GLA) { PHASE_VARS gla::phase_pre(tid, a, lds); }
    }
    SEAM(3);
    if (IN(4)) for (int rp = 0; rp < NREP(4); ++rp) { if (REPEAT_BAR && rp > 0) { const int tid_ = FRESH_TID(); const Args a_ = fresh_args(); xcd_barrier(tid_, (unsigned*)(a_.ws + WS_CTL + CTL_BAR), (volatile unsigned*)(lds + MISC_OFF)); }
        if (EN_GLA) { PHASE_VARS gla::phase_seq(tid, a, lds); }
        if (EN_MLA) { PHASE_VARS
            unsigned* qh = (unsigned*)(ws + WS_CTL + CTL_QUEUE) + 64 * ((bx & 7) + 8 * rp); volatile unsigned* qs = (volatile unsigned*)(lds + MISC_OFF + 16);
            for (;;) { { const int tq = FRESH_TID(); if (tq == 0) qs[0] = __hip_atomic_fetch_add(qh, 1u, __ATOMIC_RELAXED, __HIP_MEMORY_SCOPE_AGENT); }
                __syncthreads(); const unsigned j = (unsigned)__builtin_amdgcn_readfirstlane((int)qs[0]); __syncthreads();
                if (j >= 64u) break;
                const int bh = 4 * (bx & 7) + (int)(j & 3u), qb = 15 - (int)(j >> 2); att::attn_block(wave_s, a, lds, bh >> 3, bh & 7, qb); } }
        else { PHASE_VARS for (size_t i = (size_t)bx * NTHREADS + tid; i < (size_t)NTOK * 1024 / 8; i += (size_t)G * NTHREADS) { const size_t r = i >> 7, c8 = i & 127; *(u32x4*)(hbuf + r * DM + c8 * 8) = (u32x4){0u, 0u, 0u, 0u}; } }
    }
    SEAM(4);
    if (IN(5)) for (int rp = 0; rp < NREP(5); ++rp) { if (REPEAT_BAR && rp > 0) { const int tid_ = FRESH_TID(); const Args a_ = fresh_args(); xcd_barrier(tid_, (unsigned*)(a_.ws + WS_CTL + CTL_BAR), (volatile unsigned*)(lds + MISC_OFF)); }
        if (EN_GLA) { PHASE_VARS gla::phase_post(tid, a); }
        else { PHASE_VARS for (size_t i = (size_t)bx * NTHREADS + tid; i < (size_t)NTOK * 1024 / 8; i += (size_t)G * NTHREADS) { const size_t r = i >> 7, c8 = i & 127; *(u32x4*)(hbuf + r * DM + 1024 + c8 * 8) = (u32x4){0u, 0u, 0u, 0u}; } }
    }
    SEAM(5);
    if (IN(6)) for (int rp = 0; rp < NREP(6); ++rp) { if (REPEAT_BAR && rp > 0) { const int tid_ = FRESH_TID(); const Args a_ = fresh_args(); xcd_barrier(tid_, (unsigned*)(a_.ws + WS_CTL + CTL_BAR), (volatile unsigned*)(lds + MISC_OFF)); } PHASE_VARS pg8::Gemm g{hbuf, (const bf16_t*)(ws + WS_BTOUT), NTOK, DM, DM / 2, DM / 2, DM / 2, 0}; pg8::StaticOrder S; S.init(NTOK, DM, G, bx);
        pg8::EpiOut E{a.x, (bf16_t*)(ws + WS_X1), (bf16_t*)(ws + WS_Y), modz, a.ada_b, a.ffn_g, ssx1, rp == NREP(6) - 1, 1.f / (FP8_SA * FP8_SB)}; pg8::gemm_phase<true>(tid, lds3, g, S, E); }
    if (IN(7)) for (int rp = 0; rp < NREP(7); ++rp) { if (REPEAT_BAR && rp > 0) { const int tid_ = FRESH_TID(); const Args a_ = fresh_args(); xcd_barrier(tid_, (unsigned*)(a_.ws + WS_CTL + CTL_BAR), (volatile unsigned*)(lds + MISC_OFF)); } { PHASE_VARS phase_tables(tid, a, lds); } }
    SEAM(7);
    if (IN(8)) for (int rp = 0; rp < NREP(8); ++rp) { if (REPEAT_BAR && rp > 0) { const int tid_ = FRESH_TID(); const Args a_ = fresh_args(); xcd_barrier(tid_, (unsigned*)(a_.ws + WS_CTL + CTL_BAR), (volatile unsigned*)(lds + MISC_OFF)); }
        PHASE_VARS pg8::Gemm g{(const bf16_t*)(ws + WS_Y), (const bf16_t*)(ws + WS_BTQ), NTOK, DM, DM, DM, DM, 0}; pg8::StaticOrder S; S.init(NTOK, DM, G, bx);
        pg8::EpiTopK E{(int*)(ws + WS_EXPERTS), (float*)(ws + WS_GATES), ssx1, (const float*)(ws + WS_CSH), (unsigned short*)(ws + WS_EXP16)};
        for (int i = 0; ; ++i) { pg8::Unit un; if (!S.next(i, un)) break; pg8::SingleUnit S1{un}; pg8::gemm_phase(tid, lds3, g, S1, E); } }
    SEAM(8);
    if (IN(9) && !IN(8) && IN(10)) {}
    if (IN(10)) for (int rp = 0; rp < NREP(10); ++rp) { if (REPEAT_BAR && rp > 0) { const int tid_ = FRESH_TID(); const Args a_ = fresh_args(); xcd_barrier(tid_, (unsigned*)(a_.ws + WS_CTL + CTL_BAR), (volatile unsigned*)(lds + MISC_OFF)); } PHASE_VARS peer::phase_u(tid, a); }
    SEAM(10);
    if (IN(11)) for (int rp = 0; rp < NREP(11); ++rp) { if (REPEAT_BAR && rp > 0) { const int tid_ = FRESH_TID(); const Args a_ = fresh_args(); xcd_barrier(tid_, (unsigned*)(a_.ws + WS_CTL + CTL_BAR), (volatile unsigned*)(lds + MISC_OFF)); } PHASE_VARS peer::phase_w(tid, a); }
    SEAM(11);
    if (IN(12)) for (int rp = 0; rp < NREP(12); ++rp) { if (REPEAT_BAR && rp > 0) { const int tid_ = FRESH_TID(); const Args a_ = fresh_args(); xcd_barrier(tid_, (unsigned*)(a_.ws + WS_CTL + CTL_BAR), (volatile unsigned*)(lds + MISC_OFF)); } PHASE_VARS peer::phase_v(tid, a); }
    SEAM(12);
    if (IN(13)) { PHASE_VARS peer::phase_final(tid, a); }
#undef IN
#undef SEAM
#undef PHASE_VARS
#undef FRESH_TID
}

#ifndef N_LAUNCH_MODE
#define N_LAUNCH_MODE 1
#endif
extern "C" void kernel_launch(void* const* d_in, const int* in_sizes, int n_in, void* d_out, int out_size, void* d_ws, size_t ws_size, hipStream_t stream) {
    static int grid = 0;
    if (grid == 0) {
        if (n_in != 22 || out_size != NTOK * DM || ws_size < WS_NEED) { fprintf(stderr, "kernel_launch: unexpected problem (n_in %d, out %d, ws %zu)\n", n_in, out_size, ws_size); grid = -1; return; }
        int dev = 0, cus = 0, per_cu = 0;
        (void)hipGetDevice(&dev); (void)hipDeviceGetAttribute(&cus, hipDeviceAttributeMultiprocessorCount, dev);
        if (hipFuncSetAttribute((const void*)mega, hipFuncAttributeMaxDynamicSharedMemorySize, LDS_BYTES) != hipSuccess) { fprintf(stderr, "kernel_launch: hipFuncSetAttribute failed\n"); grid = -1; return; }
        if (hipOccupancyMaxActiveBlocksPerMultiprocessor(&per_cu, (const void*)mega, NTHREADS, LDS_BYTES) != hipSuccess || per_cu < 1) { fprintf(stderr, "kernel_launch: occupancy query says %d\n", per_cu); per_cu = 1; }
        (void)hipGetLastError();
        grid = cus * 1;
        if (per_cu < 1) grid = -1;
        fprintf(stderr, "kernel_launch: cus %d per_cu %d grid %d\n", cus, per_cu, grid);
    }
    if (grid < 0) return;
    (void)hipMemsetAsync((char*)d_ws + WS_CTL, 0, CTL_BYTES, stream);
    Args a{};
    a.x = (const float*)d_in[0]; a.c = (const float*)d_in[1]; a.pos = (const int*)d_in[2]; a.ada_w = (const float*)d_in[3]; a.ada_b = (const float*)d_in[4]; a.mix_g = (const float*)d_in[5];
    a.w_in = (const float*)d_in[6]; a.qn_g = (const float*)d_in[7]; a.w_uq = (const float*)d_in[8]; a.kvn_g = (const float*)d_in[9]; a.w_ukv = (const float*)d_in[10]; a.mla_og = (const float*)d_in[11];
    a.w_gate2 = (const float*)d_in[12]; a.b_gate = (const float*)d_in[13]; a.gla_og = (const float*)d_in[14]; a.w_out = (const float*)d_in[15]; a.ffn_g = (const float*)d_in[16];
    a.w_q = (const float*)d_in[17]; a.sub_keys = (const float*)d_in[18]; a.u_tab = (const float*)d_in[19]; a.v_tab = (const float*)d_in[20]; a.fin_g = (const float*)d_in[21];
    a.out = (float*)d_out; a.ws = (unsigned char*)d_ws;
#if N_LAUNCH_MODE == 1
    a.ph_lo = 0; a.ph_hi = NPHASE;
    void* args[] = {&a};
    hipError_t e = hipLaunchCooperativeKernel((const void*)mega, dim3(grid), dim3(NTHREADS), args, LDS_BYTES, stream);
    if (e != hipSuccess) fprintf(stderr, "kernel_launch: cooperative launch failed: %s (grid %d)\n", hipGetErrorString(e), grid);
#else
    for (int p = 0; p < NPHASE; ++p) { a.ph_lo = p; a.ph_hi = p + 1; hipLaunchKernelGGL(mega, dim3(grid), dim3(NTHREADS), LDS_BYTES, stream, a); }
#endif
}
```
